# Optimizing an MI355X kernel written in HIP

```python
import math
import jax, jax.numpy as jnp
from jax import lax
import numpy as np

D_MODEL = 1024
BATCH = 8
SEQ = 4096
DEPTH = 1

DA_HEADS = 8
DA_HEAD_DIM = 64
DA_V_DIM = 2 * DA_HEAD_DIM
DA_ROT_DIM = DA_HEAD_DIM // 4
MLA_HEADS = 8
MLA_Q_LORA = 384
MLA_KV_LORA = 256
MLA_NOPE = 128
MLA_ROPE = 64
MLA_V = 128
ROPE_THETA = 500000.0
N_GROUPS = 4
EXPERTS_PER_GROUP = 8
N_EXPERTS = N_GROUPS * EXPERTS_PER_GROUP
TOP_K = 2
D_EXPERT = 512
MOE_BLOCK = 128
Q_BLOCK = 128
NORM_EPS = 1e-6

DA_Q_COLS = DA_HEADS * 2 * DA_HEAD_DIM
DA_K_COLS = DA_HEADS * 2 * DA_HEAD_DIM
DA_V_COLS = DA_HEADS * DA_V_DIM
GATE_COLS = 2 * D_MODEL
IN_COLS = DA_Q_COLS + DA_K_COLS + DA_V_COLS + MLA_Q_LORA + MLA_KV_LORA + MLA_ROPE + GATE_COLS
SPLIT_1 = DA_Q_COLS
SPLIT_2 = SPLIT_1 + DA_K_COLS
SPLIT_3 = SPLIT_2 + DA_V_COLS
SPLIT_4 = SPLIT_3 + MLA_Q_LORA
SPLIT_5 = SPLIT_4 + MLA_KV_LORA
SPLIT_6 = SPLIT_5 + MLA_ROPE

kernel_name = 'hybrid_diffattn_mla_hmoe_block'


def rms_norm(x, g):
    xf = x.astype(jnp.float32)
    y = xf * lax.rsqrt(jnp.mean(xf * xf, axis=-1, keepdims=True) + NORM_EPS)
    return (y * g.astype(jnp.float32)).astype(x.dtype)


def rope_tables(positions, dim):
    inv = ROPE_THETA ** (-jnp.arange(0, dim, 2, dtype=jnp.float32) / dim)
    ang = positions.astype(jnp.float32)[..., None] * inv
    return jnp.cos(ang), jnp.sin(ang)


def apply_rope(x, cos, sin):
    x1, x2 = jnp.split(x, 2, axis=-1)
    c = cos[:, :, None, :]
    s = sin[:, :, None, :]
    return jnp.concatenate([x1 * c - x2 * s, x2 * c + x1 * s], axis=-1).astype(x.dtype)


def partial_rope(x, cos, sin, rot_dim):
    return jnp.concatenate([apply_rope(x[..., :rot_dim], cos, sin), x[..., rot_dim:]], axis=-1)


def causal_block_attention(q_maps, k_maps, coefs, v, scale):
    S = v.shape[1]
    n_blocks = S // Q_BLOCK
    outs = []
    for i in range(n_blocks):
        q0, q1 = i * Q_BLOCK, (i + 1) * Q_BLOCK
        mask = jnp.arange(q1)[None, :] <= jnp.arange(q0, q1)[:, None]
        w = None
        for q, k, c in zip(q_maps, k_maps, coefs):
            s = jnp.einsum('bqhd,bkhd->bhqk', q[:, q0:q1], k[:, :q1],
                           preferred_element_type=jnp.float32) * scale
            p = jax.nn.softmax(jnp.where(mask, s, -jnp.inf), axis=-1) * c
            w = p if w is None else w + p
        outs.append(jnp.einsum('bhqk,bkhd->bqhd', w.astype(v.dtype), v[:, :q1]))
    return jnp.concatenate(outs, axis=1)


def diff_attention(q, k, v, cos, sin, q_g, k_g, lq1, lk1, lq2, lk2, subln_g, lambda_init):
    B, S = q.shape[:2]
    q = partial_rope(rms_norm(q.reshape(B, S, 2 * DA_HEADS, DA_HEAD_DIM), q_g), cos, sin, DA_ROT_DIM)
    k = partial_rope(rms_norm(k.reshape(B, S, 2 * DA_HEADS, DA_HEAD_DIM), k_g), cos, sin, DA_ROT_DIM)
    v = v.reshape(B, S, DA_HEADS, DA_V_DIM)
    f32 = jnp.float32
    lam = (jnp.exp(jnp.sum(lq1.astype(f32) * lk1.astype(f32)))
           - jnp.exp(jnp.sum(lq2.astype(f32) * lk2.astype(f32))) + lambda_init)
    o = causal_block_attention([q[:, :, 0::2], q[:, :, 1::2]], [k[:, :, 0::2], k[:, :, 1::2]],
                               [1.0, -lam], v, DA_HEAD_DIM ** -0.5)
    o = rms_norm(o, subln_g) * (1.0 - lambda_init)
    return o.reshape(B, S, DA_HEADS * DA_V_DIM)


def mla_attention(c_q, c_kv, k_rope, cos, sin, q_lora_g, w_uq, kv_lora_g, w_ukv, q_g, k_nope_g, k_rope_g):
    B, S = c_q.shape[:2]
    q = (rms_norm(c_q, q_lora_g) @ w_uq).reshape(B, S, MLA_HEADS, MLA_NOPE + MLA_ROPE)
    kv = (rms_norm(c_kv, kv_lora_g) @ w_ukv).reshape(B, S, MLA_HEADS, MLA_NOPE + MLA_V)
    k_nope, v = kv[..., :MLA_NOPE], kv[..., MLA_NOPE:]
    q = rms_norm(q, q_g)
    q = jnp.concatenate([q[..., :MLA_NOPE], apply_rope(q[..., MLA_NOPE:], cos, sin)], axis=-1)
    k_nope = rms_norm(k_nope, k_nope_g)
    k_r = apply_rope(rms_norm(k_rope, k_rope_g)[:, :, None, :], cos, sin)
    k = jnp.concatenate([k_nope, jnp.broadcast_to(k_r, (B, S, MLA_HEADS, MLA_ROPE))], axis=-1)
    o = causal_block_attention([q], [k], [1.0], v, (MLA_NOPE + MLA_ROPE) ** -0.5)
    return o.reshape(B, S, MLA_HEADS * MLA_V)


def hier_moe(h, w_group, b_group, w_router, b_router, w1, w3, w2):
    B, S, D = h.shape
    T = B * S
    hf = h.reshape(T, D)
    f32 = jnp.float32
    glog = (hf @ w_group).astype(f32) + b_group.astype(f32)
    g_sel = jnp.argmax(glog, axis=-1)
    p_g = jnp.take_along_axis(jax.nn.softmax(glog, axis=-1), g_sel[:, None], axis=-1)
    elog = ((hf @ w_router).astype(f32) + b_router.astype(f32)).reshape(T, N_GROUPS, EXPERTS_PER_GROUP)
    elog = jnp.take_along_axis(elog, g_sel[:, None, None], axis=1)[:, 0]
    top_v, top_i = lax.top_k(elog, TOP_K)
    weight = p_g * jax.nn.softmax(top_v, axis=-1)
    expert = g_sel[:, None] * EXPERTS_PER_GROUP + top_i
    TK = T * TOP_K
    flat_e = expert.reshape(TK)
    flat_tok = jnp.repeat(jnp.arange(T, dtype=jnp.int32), TOP_K)
    order = jnp.argsort(flat_e)
    se, stok, sw = flat_e[order], flat_tok[order], weight.reshape(TK)[order]
    counts = jnp.bincount(flat_e, length=N_EXPERTS)
    starts = jnp.cumsum(counts) - counts
    padded = (counts + MOE_BLOCK - 1) // MOE_BLOCK * MOE_BLOCK
    pends = jnp.cumsum(padded)
    pstarts = pends - padded
    dest = pstarts[se] + (jnp.arange(TK) - starts[se])
    n_chunks = -(-TK // MOE_BLOCK) + N_EXPERTS
    P = n_chunks * MOE_BLOCK
    row_tok = jnp.full((P,), T, dtype=jnp.int32).at[dest].set(stok)
    x_pad = jnp.concatenate([hf, jnp.zeros((1, D), hf.dtype)], axis=0)
    xb = x_pad[row_tok].reshape(n_chunks, MOE_BLOCK, D)
    chunk_e = jnp.minimum(jnp.searchsorted(pends, jnp.arange(n_chunks) * MOE_BLOCK, side='right'),
                          N_EXPERTS - 1)

    def expert_ffn(args):
        xc, e = args
        return (jax.nn.silu(xc @ w1[e]) * (xc @ w3[e])) @ w2[e]

    yb = lax.map(expert_ffn, (xb, chunk_e)).reshape(P, D)
    y = (yb[dest].astype(f32) * sw[:, None]).astype(h.dtype)
    out = jax.ops.segment_sum(y, stok, num_segments=T)
    return out.reshape(B, S, D)


def setup_inputs(seed: int = 0) -> dict:
    key = jax.random.key(seed)
    ks = jax.random.split(key, 32)
    L, D = DEPTH, D_MODEL
    f32 = jnp.float32

    def nrm(k, shape, scale):
        return jax.random.normal(k, shape, f32) * scale

    def gain(k, shape):
        return 1.0 + 0.02 * jax.random.normal(k, shape, f32)

    x = jax.random.normal(ks[0], (BATCH, SEQ, D), f32)
    offsets = jax.random.randint(ks[1], (BATCH, 1), 0, 2048, dtype=jnp.int32)
    positions = offsets + jnp.arange(SEQ, dtype=jnp.int32)[None, :]
    return {
        'x': x,
        'positions': positions,
        'attn_norm_g': gain(ks[2], (L, D)),
        'w_in': nrm(ks[3], (L, D, IN_COLS), D ** -0.5),
        'b_gate': nrm(ks[4], (L, 2, D), 0.02),
        'da_q_norm_g': gain(ks[5], (L, DA_HEAD_DIM)),
        'da_k_norm_g': gain(ks[6], (L, DA_HEAD_DIM)),
        'da_lambda_q1': nrm(ks[7], (L, DA_HEAD_DIM), 0.1),
        'da_lambda_k1': nrm(ks[8], (L, DA_HEAD_DIM), 0.1),
        'da_lambda_q2': nrm(ks[9], (L, DA_HEAD_DIM), 0.1),
        'da_lambda_k2': nrm(ks[10], (L, DA_HEAD_DIM), 0.1),
        'da_subln_g': gain(ks[11], (L, DA_V_DIM)),
        'mla_q_lora_g': gain(ks[12], (L, MLA_Q_LORA)),
        'mla_w_uq': nrm(ks[13], (L, MLA_Q_LORA, MLA_HEADS * (MLA_NOPE + MLA_ROPE)), MLA_Q_LORA ** -0.5),
        'mla_kv_lora_g': gain(ks[14], (L, MLA_KV_LORA)),
        'mla_w_ukv': nrm(ks[15], (L, MLA_KV_LORA, MLA_HEADS * (MLA_NOPE + MLA_V)), MLA_KV_LORA ** -0.5),
        'mla_q_norm_g': gain(ks[16], (L, MLA_NOPE + MLA_ROPE)),
        'mla_k_nope_norm_g': gain(ks[17], (L, MLA_NOPE)),
        'mla_k_rope_norm_g': gain(ks[18], (L, MLA_ROPE)),
        'w_o': nrm(ks[19], (L, D, D), D ** -0.5),
        'ffn_norm_g': gain(ks[20], (L, D)),
        'w_group': nrm(ks[21], (L, D, N_GROUPS), D ** -0.5),
        'b_group': nrm(ks[22], (L, N_GROUPS), 0.01),
        'w_router': nrm(ks[23], (L, D, N_EXPERTS), D ** -0.5),
        'b_router': nrm(ks[24], (L, N_EXPERTS), 0.01),
        'w1': nrm(ks[25], (L, N_EXPERTS, D, D_EXPERT), D ** -0.5),
        'w3': nrm(ks[26], (L, N_EXPERTS, D, D_EXPERT), D ** -0.5),
        'w2': nrm(ks[27], (L, N_EXPERTS, D_EXPERT, D), D_EXPERT ** -0.5),
    }


def reference(x, positions, attn_norm_g, w_in, b_gate, da_q_norm_g, da_k_norm_g,
              da_lambda_q1, da_lambda_k1, da_lambda_q2, da_lambda_k2, da_subln_g,
              mla_q_lora_g, mla_w_uq, mla_kv_lora_g, mla_w_ukv, mla_q_norm_g,
              mla_k_nope_norm_g, mla_k_rope_norm_g, w_o, ffn_norm_g, w_group, b_group,
              w_router, b_router, w1, w3, w2):
    B, S, D = x.shape
    da_cos, da_sin = rope_tables(positions, DA_ROT_DIM)
    mla_cos, mla_sin = rope_tables(positions, MLA_ROPE)
    for l in range(DEPTH):
        lambda_init = 0.8 - 0.6 * math.exp(-0.3 * l)
        h = rms_norm(x, attn_norm_g[l])
        proj = h @ w_in[l]
        da_q, da_k, da_v, c_q, c_kv, k_rope, gate_logits = jnp.split(
            proj, [SPLIT_1, SPLIT_2, SPLIT_3, SPLIT_4, SPLIT_5, SPLIT_6], axis=-1)
        o_da = diff_attention(da_q, da_k, da_v, da_cos, da_sin, da_q_norm_g[l], da_k_norm_g[l],
                              da_lambda_q1[l], da_lambda_k1[l], da_lambda_q2[l], da_lambda_k2[l],
                              da_subln_g[l], lambda_init)
        o_mla = mla_attention(c_q, c_kv, k_rope, mla_cos, mla_sin, mla_q_lora_g[l], mla_w_uq[l],
                              mla_kv_lora_g[l], mla_w_ukv[l], mla_q_norm_g[l],
                              mla_k_nope_norm_g[l], mla_k_rope_norm_g[l])
        gates = jax.nn.sigmoid(gate_logits.astype(jnp.float32).reshape(B, S, 2, D)
                               + b_gate[l].astype(jnp.float32))
        mixed = (gates[:, :, 0] * o_da.astype(jnp.float32)
                 + gates[:, :, 1] * o_mla.astype(jnp.float32)).astype(x.dtype)
        x = x + mixed @ w_o[l]
        h2 = rms_norm(x, ffn_norm_g[l])
        x = x + hier_moe(h2, w_group[l], b_group[l], w_router[l], b_router[l], w1[l], w3[l], w2[l])
    return x
```

```cpp
#include <hip/hip_runtime.h>
#include <hip/hip_cooperative_groups.h>
#include <cstdio>
#include <cstdint>
namespace cg = cooperative_groups;

#ifndef PROBE_REP_MASK
#define PROBE_REP_MASK 0
#endif
#ifndef PROBE_VARIANTS
#define PROBE_VARIANTS 0
#endif
#ifndef N_LAUNCH_SPLIT
#define N_LAUNCH_SPLIT 0
#endif

#define LAS __attribute__((address_space(3)))
#define GAS __attribute__((address_space(1)))
typedef unsigned short bf16_t;
typedef short bf16x8 __attribute__((ext_vector_type(8)));
typedef short s16x4 __attribute__((ext_vector_type(4)));
typedef float f32x2 __attribute__((ext_vector_type(2)));
typedef float f32x4 __attribute__((ext_vector_type(4)));
typedef float f32x16 __attribute__((ext_vector_type(16)));
typedef unsigned u32x2 __attribute__((ext_vector_type(2)));
typedef unsigned u32x4 __attribute__((ext_vector_type(4)));
typedef __bf16 bf16x2_t __attribute__((ext_vector_type(2)));
typedef GAS unsigned gu32;

constexpr int BATCH = 8, SEQ = 4096, DM = 1024, MTOK = BATCH * SEQ;
constexpr int NHEAD = 8;
constexpr int IN_COLS = 5824, NINP = 5888;
constexpr int C_K = 1024, C_V = 2048, C_CQ = 3072, C_CKV = 3456, C_KR = 3712, C_PAD = 3776, C_G = 3840;
constexpr int QLORA = 384, KVLORA = 256, MQ_N = 1536, MKV_N = 2048;
constexpr int NEXP = 32, DEXP = 512, TOPK = 2;
constexpr int MAXCHUNK = 288, PROWS = MAXCHUNK * 256;
constexpr float NORM_EPS = 1e-6f;
constexpr float LOG2E = 1.4426950408889634f;
constexpr float C2_DA = 0.125f * LOG2E;
constexpr float C2_MLA = 0.07216878364870322f * LOG2E;
constexpr float LAMBDA_INIT = 0.8f - 0.6f;
constexpr double ROPE_THETA = 500000.0;

constexpr size_t MiB = 1u << 20;
constexpr size_t WS_CTL = 0, CTL_ZERO_BYTES = 64 * 1024;
constexpr size_t WS_ROPE_DA = 1 * MiB;
constexpr size_t WS_ROPE_ML = 3 * MiB;
constexpr size_t WS_SSQ = 11 * MiB;
constexpr size_t WS_TOKE = 13 * MiB;
constexpr size_t WS_TOKW = WS_TOKE + 256 * 1024;
constexpr size_t WS_TOKP = WS_TOKW + 256 * 1024;
constexpr size_t WS_ROWTOK = 14 * MiB;
constexpr size_t WS_ROWSLOT = WS_ROWTOK + 512 * 1024;
constexpr size_t WS_ROWW = WS_ROWSLOT + 512 * 1024;
constexpr size_t WS_CHUNKE = WS_ROWW + 512 * 1024;
constexpr size_t WS_WIN = 16 * MiB;
constexpr size_t WS_WUQ = 28 * MiB;
constexpr size_t WS_WUKV = 30 * MiB;
constexpr size_t WS_WO = 504 * MiB;
constexpr size_t WS_X1 = 16 * MiB;
constexpr size_t WS_KROPE = 34 * MiB;
constexpr size_t WS_CQ = 38 * MiB;
constexpr size_t WS_CKV = 62 * MiB;
constexpr size_t WS_DAQ = 80 * MiB;
constexpr size_t WS_DAK = 144 * MiB;
constexpr size_t WS_DAV = 208 * MiB;
constexpr size_t WS_MQ = 272 * MiB;
constexpr size_t WS_MKV = 368 * MiB;
constexpr size_t WS_W13 = 144 * MiB;
constexpr size_t WS_W2 = 208 * MiB;
constexpr size_t WS_H2 = 240 * MiB;
constexpr size_t WS_HE = 304 * MiB;
constexpr size_t WS_Y = 376 * MiB;
constexpr size_t WS_END = 506 * MiB;
constexpr int CW_GCNT = 64;
constexpr int CW_BAR = 4096;
constexpr int CW_DONE = 8192, DONE_STRIDE = 16, CW_DONE2 = CW_DONE + 288 * DONE_STRIDE;

constexpr int RING_BYTES = 131072;
constexpr int EXCH_OFF = 131072;
constexpr int STAGE_ROW = 132;
constexpr int OSTG_BYTES = 32 * STAGE_ROW * 4;
constexpr int MISC_OFF = 147456;
constexpr int WSF_OFF = 147968;
constexpr int LDS_BYTES = 150528;

__device__ __forceinline__ unsigned cvtpk(float lo, float hi) { f32x2 v = {lo, hi}; bf16x2_t b = __builtin_convertvector(v, bf16x2_t); return __builtin_bit_cast(unsigned, b); }
__device__ __forceinline__ float bf_lo(unsigned w) { return __uint_as_float(w << 16); }
__device__ __forceinline__ void st16_wt(void* p, u32x4 w) { asm volatile("global_store_dwordx4 %0, %1, off sc1\n\ts_nop 2" :: "v"(p), "v"(w) : "memory"); }
#define UB(w_, k_) ((float)(((w_) >> (8 * (k_))) & 0xffu))
__device__ __forceinline__ float bf_hi(unsigned w) { return __uint_as_float(w & 0xffff0000u); }
__device__ __forceinline__ float dpp_add(float v, const int ctrl_sel) {
    const int x = __builtin_bit_cast(int, v); int y;
    if (ctrl_sel == 0) y = __builtin_amdgcn_update_dpp(x, x, 0xB1, 0xF, 0xF, false);
    else if (ctrl_sel == 1) y = __builtin_amdgcn_update_dpp(x, x, 0x4E, 0xF, 0xF, false);
    else if (ctrl_sel == 2) y = __builtin_amdgcn_update_dpp(x, x, 0x141, 0xF, 0xF, false);
    else y = __builtin_amdgcn_update_dpp(x, x, 0x140, 0xF, 0xF, false);
    return v + __builtin_bit_cast(float, y);
}
__device__ __forceinline__ float wave_sum(float v) {
    v = dpp_add(v, 0); v = dpp_add(v, 1); v = dpp_add(v, 2); v = dpp_add(v, 3);
    const int x = __builtin_bit_cast(int, v);
    const float r0 = __builtin_bit_cast(float, __builtin_amdgcn_readlane(x, 0)), r1 = __builtin_bit_cast(float, __builtin_amdgcn_readlane(x, 16));
    const float r2 = __builtin_bit_cast(float, __builtin_amdgcn_readlane(x, 32)), r3 = __builtin_bit_cast(float, __builtin_amdgcn_readlane(x, 48));
    return (r0 + r1) + (r2 + r3);
}
__device__ __forceinline__ float sigmoidf_fast(float x) { return __builtin_amdgcn_rcpf(1.0f + __builtin_amdgcn_exp2f(-x * LOG2E)); }
__device__ __forceinline__ int otid() { int t = threadIdx.x; asm volatile("" : "+v"(t)); return t; }
#define LDS_WAIT() asm volatile("s_waitcnt lgkmcnt(0)" ::: "memory")
#define VM_WAIT() asm volatile("s_waitcnt vmcnt(0)" ::: "memory")

namespace pg8 {
constexpr int BM = 256, BK = 64, HALF = 128, HTB = HALF * BK * 2, STAGE_BYTES = 8 * HTB;
__host__ __device__ __forceinline__ int lds_byte(int r, int c) { const int st = (r >> 4) * 2 + (c >> 5), rr = r & 15, cc = c & 31, ob = rr * 64 + cc * 2; return st * 1024 + (ob ^ (((ob >> 9) & 1) << 5)); }
__host__ __device__ __forceinline__ void stage_rc(int b, int& R, int& C) { const int st = b / 1024, sb = b % 1024, swz = sb ^ (((sb >> 9) & 1) << 5); R = (st >> 1) * 16 + swz / 64; C = (st & 1) * 32 + (swz % 64) / 2; }
__host__ __device__ __forceinline__ int perm32(int rho) { const int n = rho >> 4, i = rho & 15; return 8 * (i >> 2) + 4 * n + (i & 3); }

struct Unit { int pm, pn, brow; };

template <class Epi, class Sched, bool ALIGN_EPI>
__device__ __forceinline__ void gemm_phase(LAS unsigned char* lds, const bf16_t* A, const bf16_t* Bt, const int K_, const Sched& S, const Epi& E) {
    constexpr int MODE = Epi::MODE; constexpr bool GATHER = Sched::GATHER;
    int K = K_; asm volatile("" : "+s"(K));
    int tid_ = threadIdx.x; asm volatile("" : "+v"(tid_));
    const int tid = tid_, wid = __builtin_amdgcn_readfirstlane(tid >> 6), lane = tid & 63, wr = wid >> 2, wc = wid & 3, fr = lane & 15, fq = lane >> 4;
    const int nt = K / BK;
    unsigned voffB[2]; unsigned vA[2]; int Rr[2], Cc[2];
#pragma unroll
    for (int i = 0; i < 2; ++i) { int R, C; stage_rc(tid * 16 + i * 8192, R, C); Rr[i] = R; Cc[i] = C;
        const int Rb = MODE == 2 ? (2 * (R & ~31) + perm32(R & 31)) : MODE == 1 ? ((R & ~31) + perm32(R & 31)) : R;
        vA[i] = (unsigned)(R * K + C) * 2u; voffB[i] = (unsigned)(Rb * K + C) * 2u; }
    const size_t kstep = (size_t)(BK * 2);
    const size_t hstepA = (size_t)HALF * K * 2;
    const size_t hstepB = MODE == 2 ? (size_t)32 * K * 2 : (size_t)HALF * K * 2;
    const size_t tstep = 2 * hstepA;
    const unsigned ldsw = (unsigned)wid * 1024u;
    const int aoff = lds_byte(wr * 64 + fr, fq * 8), boff = lds_byte(wc * 32 + fr, fq * 8);
#define PG8_SA(b, h) (((b) * 2 + (h)) * HTB)
#define PG8_SB(b, h) ((4 + (b) * 2 + (h)) * HTB)
#define PG8_STAGE(bufoff, gbase, voff) do { _Pragma("unroll") for (int _i = 0; _i < 2; ++_i) \
        __builtin_amdgcn_global_load_lds((const unsigned*)((const char*)(gbase) + (voff)[_i]), (LAS unsigned*)(lds + (bufoff) + ldsw + _i * 8192), 16, 0, 0); } while (0)
#define PG8_LDA(dst, b, h) do { _Pragma("unroll") for (int m = 0; m < 4; ++m) _Pragma("unroll") for (int k = 0; k < 2; ++k) dst[m][k] = *(const LAS bf16x8*)(lds + PG8_SA(b, h) + aoff + m * 2048 + k * 1024); } while (0)
#define PG8_LDB(dst, b, h) do { _Pragma("unroll") for (int n = 0; n < 2; ++n) _Pragma("unroll") for (int k = 0; k < 2; ++k) dst[n][k] = *(const LAS bf16x8*)(lds + PG8_SB(b, h) + boff + n * 2048 + k * 1024); } while (0)
#define PG8_MMA(ai, bj, At, Bt_) do { __builtin_amdgcn_s_setprio(1); _Pragma("unroll") for (int m = 0; m < 4; ++m) _Pragma("unroll") for (int n = 0; n < 2; ++n) _Pragma("unroll") for (int k = 0; k < 2; ++k) \
        acc[ai][bj][m][n] = __builtin_amdgcn_mfma_f32_16x16x32_bf16(Bt_[n][k], At[m][k], acc[ai][bj][m][n], 0, 0, 0); __builtin_amdgcn_s_setprio(0); } while (0)
#define PG8_WAIT_V(n) asm volatile("s_waitcnt vmcnt(" #n ")" ::: "memory")
#define PG8_WAIT_L(n) asm volatile("s_waitcnt lgkmcnt(" #n ")" ::: "memory")
#define PG8_BAR __builtin_amdgcn_s_barrier()
#define PG8_SCHED __builtin_amdgcn_sched_barrier(0)
    Unit cur, nxt; int ui = 0;
    if (!S.next(0, cur)) return;
    if constexpr (Sched::WAITS) { if (wid == 0) S.wait(cur, lane); __builtin_amdgcn_s_barrier(); }
    int sig = -1;
    f32x4 acc[2][2][4][2];
#pragma unroll
    for (int a = 0; a < 2; ++a)
#pragma unroll
        for (int b = 0; b < 2; ++b)
#pragma unroll
            for (int m = 0; m < 4; ++m)
#pragma unroll
                for (int n = 0; n < 2; ++n) acc[a][b][m][n] = (f32x4){0.f, 0.f, 0.f, 0.f};
    bf16x8 At[4][2], B0[2][2], B1[2][2];
    unsigned cA0[2], cA1[2], nA0[2], nA1[2];
    const char* cA; const char* cB;
    if constexpr (GATHER) {
        cA = (const char*)A;
#pragma unroll
        for (int i = 0; i < 2; ++i) { cA0[i] = (unsigned)(S.row_tok[cur.pm * 256 + Rr[i]] * K + Cc[i]) * 2u; cA1[i] = (unsigned)(S.row_tok[cur.pm * 256 + 128 + Rr[i]] * K + Cc[i]) * 2u; }
    } else {
        cA = (const char*)A + (size_t)cur.pm * tstep;
#pragma unroll
        for (int i = 0; i < 2; ++i) { cA0[i] = vA[i]; cA1[i] = vA[i] + (unsigned)hstepA; }
    }
    cB = (const char*)Bt + (size_t)cur.brow * K * 2;
    PG8_STAGE(PG8_SB(0, 0), cB, voffB); PG8_STAGE(PG8_SB(0, 1), cB + hstepB, voffB); PG8_STAGE(PG8_SA(0, 0), cA, cA0); PG8_STAGE(PG8_SA(0, 1), cA, cA1);
    if (wr == 1) PG8_BAR;
    PG8_WAIT_V(2); PG8_BAR;
    PG8_STAGE(PG8_SB(1, 0), cB + kstep, voffB); PG8_STAGE(PG8_SA(1, 0), cA + kstep, cA0); PG8_STAGE(PG8_SB(1, 1), cB + hstepB + kstep, voffB);
    PG8_WAIT_V(6); PG8_BAR;
    for (;;) {
        const bool has_next = S.next(ui + 1, nxt);
        const char* nA; const char* nB;
        if (has_next) {
            nB = (const char*)Bt + (size_t)nxt.brow * K * 2;
            if constexpr (GATHER) {
                nA = (const char*)A;
#pragma unroll
                for (int i = 0; i < 2; ++i) { nA0[i] = (unsigned)(S.row_tok[nxt.pm * 256 + Rr[i]] * K + Cc[i]) * 2u; nA1[i] = (unsigned)(S.row_tok[nxt.pm * 256 + 128 + Rr[i]] * K + Cc[i]) * 2u; }
            } else {
                nA = (const char*)A + (size_t)nxt.pm * tstep;
#pragma unroll
                for (int i = 0; i < 2; ++i) { nA0[i] = cA0[i]; nA1[i] = cA1[i]; }
            }
        } else { nA = cA; nB = cB;
#pragma unroll
            for (int i = 0; i < 2; ++i) { nA0[i] = cA0[i]; nA1[i] = cA1[i]; } }
        if constexpr (Sched::WAITS) { if constexpr (Sched::PER_UNIT) { if (has_next && wid == 0) S.wait(nxt, lane); } }
        for (int t = 0; t < nt; t += 2) {
            const bool last = (t == nt - 2);
            const char* a1 = cA + (size_t)(t + 1) * kstep;
            const char* a2 = last ? nA : cA + (size_t)(t + 2) * kstep; const char* b2 = last ? nB : cB + (size_t)(t + 2) * kstep;
            const char* a3 = a2 + kstep; const char* b3 = b2 + kstep;
            unsigned o20[2], o21[2];
#pragma unroll
            for (int i = 0; i < 2; ++i) { o20[i] = last ? nA0[i] : cA0[i]; o21[i] = last ? nA1[i] : cA1[i]; }
            PG8_LDB(B0, 0, 0); PG8_LDB(B1, 0, 1); PG8_SCHED; PG8_LDA(At, 0, 0); PG8_STAGE(PG8_SA(1, 1), a1, cA1);
            PG8_WAIT_V(8); PG8_WAIT_L(0); PG8_BAR; PG8_MMA(0, 0, At, B0); PG8_MMA(0, 1, At, B1); PG8_BAR; PG8_SCHED;
            PG8_LDA(At, 0, 1); PG8_STAGE(PG8_SB(0, 0), b2, voffB); PG8_STAGE(PG8_SB(0, 1), b2 + hstepB, voffB); PG8_STAGE(PG8_SA(0, 0), a2, o20);
            PG8_WAIT_V(8); PG8_WAIT_L(0); PG8_BAR; PG8_MMA(1, 0, At, B0); PG8_MMA(1, 1, At, B1); PG8_BAR; PG8_SCHED;
            PG8_LDB(B0, 1, 0); PG8_LDB(B1, 1, 1); PG8_SCHED; PG8_LDA(At, 1, 0); PG8_STAGE(PG8_SA(0, 1), a2, o21);
            PG8_WAIT_V(8); PG8_WAIT_L(0); PG8_BAR; PG8_MMA(0, 0, At, B0); PG8_MMA(0, 1, At, B1); PG8_BAR; PG8_SCHED;
            PG8_LDA(At, 1, 1); PG8_STAGE(PG8_SB(1, 0), b3, voffB); PG8_STAGE(PG8_SB(1, 1), b3 + hstepB, voffB); PG8_STAGE(PG8_SA(1, 0), a3, o20);
            PG8_WAIT_V(8); PG8_WAIT_L(0); PG8_BAR; PG8_MMA(1, 0, At, B0); PG8_MMA(1, 1, At, B1); PG8_BAR; PG8_SCHED;
        }
        if constexpr (Epi::SIGNAL) { if (sig >= 0 && tid == 0) __hip_atomic_fetch_add(E.done + DONE_STRIDE * sig, 1u, __ATOMIC_RELAXED, __HIP_MEMORY_SCOPE_AGENT); }
        if constexpr (ALIGN_EPI) { if (wr == 0) PG8_BAR; }
        E(acc, cur, wr, wc, fr, fq, lds);
        if constexpr (Epi::SIGNAL) sig = E.sig_chunk(cur);
        if (!has_next) break;
#pragma unroll
        for (int a = 0; a < 2; ++a)
#pragma unroll
            for (int b = 0; b < 2; ++b)
#pragma unroll
                for (int m = 0; m < 4; ++m)
#pragma unroll
                    for (int n = 0; n < 2; ++n) acc[a][b][m][n] = (f32x4){0.f, 0.f, 0.f, 0.f};
        cur = nxt; cA = nA; cB = nB; ++ui;
#pragma unroll
        for (int i = 0; i < 2; ++i) { cA0[i] = nA0[i]; cA1[i] = nA1[i]; }
        if constexpr (ALIGN_EPI) { if (wr == 1) PG8_BAR; }
    }
    PG8_WAIT_V(0);
    if constexpr (!ALIGN_EPI) { if (wr == 0) PG8_BAR; }
    PG8_BAR;
    if constexpr (Epi::SIGNAL) { if (sig >= 0 && tid == 0) __hip_atomic_fetch_add(E.done + DONE_STRIDE * sig, 1u, __ATOMIC_RELAXED, __HIP_MEMORY_SCOPE_AGENT); }
#undef PG8_SA
#undef PG8_SB
#undef PG8_STAGE
#undef PG8_LDA
#undef PG8_LDB
#undef PG8_MMA
#undef PG8_WAIT_V
#undef PG8_WAIT_L
#undef PG8_BAR
#undef PG8_SCHED
}

struct DenseOrder {
    static constexpr bool GATHER = false, WAITS = false;
    int nM, nN, nwg, G, c; const int* row_tok;
    __device__ void init(int M, int N, int G_, int c_) { nM = M / BM; nN = N / BM; nwg = nM * nN; G = G_; c = c_; row_tok = nullptr; }
    __device__ void map(int L, Unit& u) const {
        int wgid = L; { const int q = nwg / 8, r = nwg % 8, xcd = wgid % 8, off = wgid / 8; wgid = (xcd < r ? xcd * (q + 1) : r * (q + 1) + (xcd - r) * q) + off; }
        const int nig = 8 * nN, gid = wgid / nig, fm = gid * 8, gsz = (nM - fm) < 8 ? (nM - fm) : 8;
        u.pm = fm + ((wgid % nig) % gsz); u.pn = (wgid % nig) / gsz; u.brow = u.pn * 256;
    }
    __device__ bool next(int i, Unit& u) const { const long L = (long)i * G + c; if (L >= nwg) return false; map((int)L, u); return true; }
};
struct DenseOrderHand : DenseOrder {
    static constexpr bool WAITS = true, PER_UNIT = false;
    const unsigned* done; unsigned need; int ext;
    __device__ bool next(int i, Unit& u) const {
        const int rounds = nwg / G;
        if (ext <= 0 || nwg != rounds * G || 2 * ext > G || rounds < 2) return DenseOrder::next(i, u);
        int L;
        if (c < ext) { if (i >= rounds - 1) return false; L = i * G + c; }
        else if (i < rounds) L = i * G + c;
        else if (i == rounds && c - ext < ext) L = (rounds - 1) * G + (c - ext);
        else return false;
        map(L, u); return true;
    }
    __device__ __forceinline__ void wait(const Unit& u, int lane) const {
        if (lane == 0) { unsigned spins = 0;
            while (__hip_atomic_load(done, __ATOMIC_RELAXED, __HIP_MEMORY_SCOPE_AGENT) < need && ++spins < (1u << 22)) __builtin_amdgcn_s_sleep(4); }
        __builtin_amdgcn_fence(__ATOMIC_ACQUIRE, "agent");
        asm volatile("s_waitcnt vmcnt(0)" ::: "memory");
    }
};
template <bool GATHER_> struct GroupOrder {
    static constexpr bool GATHER = GATHER_, WAITS = false;
    int nunits, G, vcu; const int* chunk_e; const int* row_tok;
    __device__ bool next(int i, Unit& u) const {
        const int L = i * G + vcu; if (L >= nunits) return false;
        const int ch = L >> 2; u.pm = ch; u.pn = L & 3; u.brow = chunk_e[ch] * 1024 + (L & 3) * 256; return true;
    }
};
struct GroupOrderBal {
    static constexpr bool GATHER = false, WAITS = true, PER_UNIT = true;
    int nunits, G, vcu; const int* chunk_e; const int* row_tok; const unsigned* done;
    __device__ bool next(int i, Unit& u) const {
        const int full = nunits / G, r1 = nunits - full * G;
        int L;
        if (r1 == 0 || full < 2) { L = i * G + vcu; if (L >= nunits) return false; }
        else if (vcu < r1) { if (i >= full - 1) return false; L = i * G + vcu; }
        else if (i < full) L = i * G + vcu;
        else { const int k = (i - full) * (G - r1) + (vcu - r1); if (k >= 2 * r1) return false; L = (k < r1) ? (full - 1) * G + k : full * G + (k - r1); }
        const int ch = L >> 2; u.pm = ch; u.pn = L & 3; u.brow = chunk_e[ch] * 1024 + (L & 3) * 256; return true;
    }
    __device__ __forceinline__ void wait(const Unit& u, int lane) const {
        if (lane == 0) { const unsigned* p = done + DONE_STRIDE * u.pm; unsigned spins = 0;
            while (__hip_atomic_load(p, __ATOMIC_RELAXED, __HIP_MEMORY_SCOPE_AGENT) < 4u && ++spins < (1u << 22)) __builtin_amdgcn_s_sleep(4); }
        __builtin_amdgcn_fence(__ATOMIC_ACQUIRE, "agent");
        asm volatile("s_waitcnt vmcnt(0)" ::: "memory");
    }
};
}

namespace epi {
using pg8::Unit;
typedef f32x4 Acc[2][2][4][2];

struct EpiInProj {
    static constexpr int MODE = 2; static constexpr bool SIGNAL = true;
    bf16_t *daq, *dak, *dav, *cq, *ckv, *krope; unsigned char* gates; float* ssq; unsigned* done;
    __device__ __forceinline__ int sig_chunk(const Unit& u) const { return (u.pn >= C_CQ / 256 && u.pn < (C_PAD + 255) / 256) ? 0 : -1; }
    const float *gq, *gk, *gkr, *bgate, *rope_da, *rope_ml; bool dry;
    __device__ __forceinline__ void operator()(const Acc& acc, const Unit& u, int wr, int wc, int fr, int fq, LAS unsigned char*) const {
        if (dry) { asm volatile("" :: "v"(acc[0][0][0][0]), "v"(acc[1][1][3][1])); return; }
        const int c0 = u.pn * 256 + wc * 64;
        const int rbase = u.pm * 256 + wr * 64 + fr;
        if (c0 < C_V) {
            const bool isq = c0 < C_K; const float* g = isq ? gq : gk; bf16_t* outp = (isq ? daq : dak) + (c0 & 1023);
            const float osc = isq ? C2_DA : 1.0f;
            f32x4 gv[2][2];
#pragma unroll
            for (int bj = 0; bj < 2; ++bj)
#pragma unroll
                for (int n = 0; n < 2; ++n) gv[bj][n] = *(const f32x4*)(g + 32 * bj + 8 * fq + 4 * n) * osc;
            f32x4 tcs[2], tsn[2], ncs[2], nsn[2];
            { const float* rt0 = rope_da + (size_t)rbase * 16;
#pragma unroll
              for (int n = 0; n < 2; ++n) { tcs[n] = *(const f32x4*)(rt0 + 4 * n); tsn[n] = *(const f32x4*)(rt0 + 8 + 4 * n); } }
#pragma unroll
            for (int ai = 0; ai < 2; ++ai)
#pragma unroll
                for (int m = 0; m < 4; ++m) {
                    const int row = rbase + ai * 128 + m * 16;
                    { const int g1 = ai * 4 + m + 1; if (g1 < 8) { const float* rt1 = rope_da + (size_t)(rbase + (g1 >> 2) * 128 + (g1 & 3) * 16) * 16;
#pragma unroll
                        for (int n = 0; n < 2; ++n) { ncs[n] = *(const f32x4*)(rt1 + 4 * n); nsn[n] = *(const f32x4*)(rt1 + 8 + 4 * n); } } }
                    float ss = 0.f;
#pragma unroll
                    for (int bj = 0; bj < 2; ++bj)
#pragma unroll
                        for (int n = 0; n < 2; ++n) { const f32x4 v = acc[ai][bj][m][n]; ss += (v[0] * v[0] + v[1] * v[1]) + (v[2] * v[2] + v[3] * v[3]); }
                    ss += __shfl_xor(ss, 16); ss += __shfl_xor(ss, 32);
                    const float rinv = __builtin_amdgcn_rsqf(ss * (1.0f / 64.0f) + NORM_EPS) ;
                    f32x4 v[2][2];
#pragma unroll
                    for (int bj = 0; bj < 2; ++bj)
#pragma unroll
                        for (int n = 0; n < 2; ++n) v[bj][n] = acc[ai][bj][m][n] * rinv * gv[bj][n];
#pragma unroll
                    for (int n = 0; n < 2; ++n) {
                        const f32x4 cs = tcs[n], sn = tsn[n];
                        f32x4 pr;
#pragma unroll
                        for (int e = 0; e < 4; ++e) pr[e] = __shfl_xor(v[0][n][e], 16);
                        if (fq < 2) {
#pragma unroll
                            for (int e = 0; e < 4; ++e) v[0][n][e] = (fq == 0) ? (v[0][n][e] * cs[e] - pr[e] * sn[e]) : (v[0][n][e] * cs[e] + pr[e] * sn[e]);
                        }
                    }
                    bf16_t* rowp = outp + (size_t)row * 1024 + 8 * fq;
#pragma unroll
                    for (int bj = 0; bj < 2; ++bj) { const f32x4 a = v[bj][0], b = v[bj][1]; u32x4 w; w.x = cvtpk(a[0], a[1]); w.y = cvtpk(a[2], a[3]); w.z = cvtpk(b[0], b[1]); w.w = cvtpk(b[2], b[3]);
                        *(u32x4*)(rowp + 32 * bj) = w; }
#pragma unroll
                    for (int n = 0; n < 2; ++n) { tcs[n] = ncs[n]; tsn[n] = nsn[n]; }
                }
        } else if (c0 < C_CQ) {
#pragma unroll
            for (int ai = 0; ai < 2; ++ai)
#pragma unroll
                for (int m = 0; m < 4; ++m) { bf16_t* rowp = dav + (size_t)(rbase + ai * 128 + m * 16) * 1024 + (c0 - C_V) + 8 * fq;
#pragma unroll
                    for (int bj = 0; bj < 2; ++bj) { const f32x4 a = acc[ai][bj][m][0], b = acc[ai][bj][m][1]; u32x4 w; w.x = cvtpk(a[0], a[1]); w.y = cvtpk(a[2], a[3]); w.z = cvtpk(b[0], b[1]); w.w = cvtpk(b[2], b[3]);
                        *(u32x4*)(rowp + 32 * bj) = w; } }
        } else if (c0 < C_KR) {
            const bool iscq = c0 < C_CKV; const int cc = iscq ? (c0 - C_CQ) : (c0 - C_CKV); const int ld = iscq ? QLORA : KVLORA;
            bf16_t* outp = (iscq ? cq : ckv) + cc; const int sidx = iscq ? (cc >> 6) : (8 + (cc >> 6));
#pragma unroll
            for (int ai = 0; ai < 2; ++ai)
#pragma unroll
                for (int m = 0; m < 4; ++m) { const int row = rbase + ai * 128 + m * 16; bf16_t* rowp = outp + (size_t)row * ld + 8 * fq; float ss = 0.f;
#pragma unroll
                    for (int bj = 0; bj < 2; ++bj) { const f32x4 a = acc[ai][bj][m][0], b = acc[ai][bj][m][1];
                        ss += (a[0] * a[0] + a[1] * a[1]) + (a[2] * a[2] + a[3] * a[3]) + (b[0] * b[0] + b[1] * b[1]) + (b[2] * b[2] + b[3] * b[3]);
                        u32x4 w; w.x = cvtpk(a[0], a[1]); w.y = cvtpk(a[2], a[3]); w.z = cvtpk(b[0], b[1]); w.w = cvtpk(b[2], b[3]);
                        st16_wt(rowp + 32 * bj, w); }
                    ss += __shfl_xor(ss, 16); ss += __shfl_xor(ss, 32);
                    if (fq == 0) __hip_atomic_store(ssq + (size_t)row * 16 + sidx, ss, __ATOMIC_RELAXED, __HIP_MEMORY_SCOPE_AGENT); }
        } else if (c0 == C_KR) {
            f32x4 gv[2][2];
#pragma unroll
            for (int bj = 0; bj < 2; ++bj)
#pragma unroll
                for (int n = 0; n < 2; ++n) gv[bj][n] = *(const f32x4*)(gkr + 32 * bj + 8 * fq + 4 * n);
#pragma unroll
            for (int ai = 0; ai < 2; ++ai)
#pragma unroll
                for (int m = 0; m < 4; ++m) {
                    const int row = rbase + ai * 128 + m * 16;
                    float ss = 0.f;
#pragma unroll
                    for (int bj = 0; bj < 2; ++bj)
#pragma unroll
                        for (int n = 0; n < 2; ++n) { const f32x4 v = acc[ai][bj][m][n]; ss += (v[0] * v[0] + v[1] * v[1]) + (v[2] * v[2] + v[3] * v[3]); }
                    ss += __shfl_xor(ss, 16); ss += __shfl_xor(ss, 32);
                    const float rinv = __builtin_amdgcn_rsqf(ss * (1.0f / 64.0f) + NORM_EPS);
                    const float* rt = rope_ml + (size_t)row * 64 + 8 * fq;
                    bf16_t* rowp = krope + (size_t)row * 64 + 8 * fq;
                    f32x4 o1[2], o2[2];
#pragma unroll
                    for (int n = 0; n < 2; ++n) { const f32x4 cs = *(const f32x4*)(rt + 4 * n), sn = *(const f32x4*)(rt + 32 + 4 * n);
                        const f32x4 x1 = acc[ai][0][m][n] * rinv * gv[0][n], x2 = acc[ai][1][m][n] * rinv * gv[1][n];
                        o1[n] = x1 * cs - x2 * sn; o2[n] = x2 * cs + x1 * sn; }
                    u32x4 w; w.x = cvtpk(o1[0][0], o1[0][1]); w.y = cvtpk(o1[0][2], o1[0][3]); w.z = cvtpk(o1[1][0], o1[1][1]); w.w = cvtpk(o1[1][2], o1[1][3]);
                    *(u32x4*)(rowp) = w;
                    w.x = cvtpk(o2[0][0], o2[0][1]); w.y = cvtpk(o2[0][2], o2[0][3]); w.z = cvtpk(o2[1][0], o2[1][1]); w.w = cvtpk(o2[1][2], o2[1][3]);
                    *(u32x4*)(rowp + 32) = w;
                }
        } else if (c0 >= C_G) {
            const int gc = c0 - C_G;
            f32x4 bv[2][2];
#pragma unroll
            for (int bj = 0; bj < 2; ++bj)
#pragma unroll
                for (int n = 0; n < 2; ++n) bv[bj][n] = *(const f32x4*)(bgate + gc + 32 * bj + 8 * fq + 4 * n) * (-LOG2E);
#pragma unroll
            for (int ai = 0; ai < 2; ++ai)
#pragma unroll
                for (int m = 0; m < 4; ++m) { unsigned char* rowp = gates + (size_t)(rbase + ai * 128 + m * 16) * 2048 + gc + 8 * fq;
#pragma unroll
                    for (int bj = 0; bj < 2; ++bj) { const f32x4 a = acc[ai][bj][m][0] * (-LOG2E) + bv[bj][0], b = acc[ai][bj][m][1] * (-LOG2E) + bv[bj][1]; u32x2 w = {0u, 0u};
#define SG2(x_) __builtin_floorf(__builtin_amdgcn_rcpf(1.0f + __builtin_amdgcn_exp2f(x_)) * 255.0f + 0.5f)
#pragma unroll
                        for (int e = 0; e < 4; ++e) { w.x = __builtin_amdgcn_cvt_pk_u8_f32(SG2(a[e]), e, w.x); w.y = __builtin_amdgcn_cvt_pk_u8_f32(SG2(b[e]), e, w.y); }
#undef SG2
                        *(u32x2*)(rowp + 32 * bj) = w; } }
        }
    }
};

struct EpiMlaQ {
    static constexpr int MODE = 1; static constexpr bool SIGNAL = false;
    bf16_t* mq; const float* ssq;
    __device__ __forceinline__ void operator()(const Acc& acc, const Unit& u, int wr, int wc, int fr, int fq, LAS unsigned char*) const {
        const int rbase = u.pm * 256 + wr * 64 + fr; const int col0 = u.pn * 256 + wc * 32 + 8 * fq;
        float rinvs[2][4];
#pragma unroll
        for (int ai = 0; ai < 2; ++ai)
#pragma unroll
            for (int m = 0; m < 4; ++m) { const size_t row = (size_t)(rbase + ai * 128 + m * 16);
                const f32x4 s4 = *(const f32x4*)(ssq + row * 16); const f32x2 s2 = *(const f32x2*)(ssq + row * 16 + 4);
                rinvs[ai][m] = __builtin_amdgcn_rsqf(((s4[0] + s4[1]) + (s4[2] + s4[3]) + (s2[0] + s2[1])) * (1.0f / 384.0f) + NORM_EPS); }
#pragma unroll
        for (int ai = 0; ai < 2; ++ai)
#pragma unroll
            for (int m = 0; m < 4; ++m) { const int row = rbase + ai * 128 + m * 16;
                const float rinv = rinvs[ai][m];
                bf16_t* rowp = mq + (size_t)row * MQ_N + col0;
#pragma unroll
                for (int bj = 0; bj < 2; ++bj) { const f32x4 a = acc[ai][bj][m][0] * rinv, b = acc[ai][bj][m][1] * rinv; u32x4 w; w.x = cvtpk(a[0], a[1]); w.y = cvtpk(a[2], a[3]); w.z = cvtpk(b[0], b[1]); w.w = cvtpk(b[2], b[3]);
                    *(u32x4*)(rowp + 128 * bj) = w; } }
    }
};

struct EpiMlaKV {
    static constexpr int MODE = 2; static constexpr bool SIGNAL = false;
    bf16_t* mkv; const float* ssq; const float* gkn;
    __device__ __forceinline__ void operator()(const Acc& acc, const Unit& u, int wr, int wc, int fr, int fq, LAS unsigned char* lds) const {
        LAS float* X = (LAS float*)(lds + EXCH_OFF);
        const int rl = wr * 64 + fr; const int rbase = u.pm * 256 + rl;
        float rinv[2][4];
#pragma unroll
        for (int ai = 0; ai < 2; ++ai)
#pragma unroll
            for (int m = 0; m < 4; ++m) { const f32x4 s4 = *(const f32x4*)(ssq + (size_t)(rbase + ai * 128 + m * 16) * 16 + 8);
                rinv[ai][m] = __builtin_amdgcn_rsqf(((s4[0] + s4[1]) + (s4[2] + s4[3])) * (1.0f / 256.0f) + NORM_EPS); }
        if (wc < 2) {
#pragma unroll
            for (int ai = 0; ai < 2; ++ai)
#pragma unroll
                for (int m = 0; m < 4; ++m) { float ss = 0.f;
#pragma unroll
                    for (int bj = 0; bj < 2; ++bj)
#pragma unroll
                        for (int n = 0; n < 2; ++n) { const f32x4 v = acc[ai][bj][m][n] * rinv[ai][m]; ss += (v[0] * v[0] + v[1] * v[1]) + (v[2] * v[2] + v[3] * v[3]); }
                    ss += __shfl_xor(ss, 16); ss += __shfl_xor(ss, 32);
                    if (fq == 0) X[(rl + ai * 128 + m * 16) * 2 + wc] = ss; }
        }
        asm volatile("s_waitcnt lgkmcnt(0)\n\ts_barrier" ::: "memory");
        f32x4 gv[2][2];
#pragma unroll
        for (int bj = 0; bj < 2; ++bj)
#pragma unroll
            for (int n = 0; n < 2; ++n) gv[bj][n] = (wc < 2) ? *(const f32x4*)(gkn + 64 * wc + 32 * bj + 8 * fq + 4 * n) : (f32x4){1.f, 1.f, 1.f, 1.f};
#pragma unroll
        for (int ai = 0; ai < 2; ++ai)
#pragma unroll
            for (int m = 0; m < 4; ++m) { float sc = rinv[ai][m];
                if (wc < 2) { const f32x2 t = *(const LAS f32x2*)(X + (rl + ai * 128 + m * 16) * 2); sc *= __builtin_amdgcn_rsqf((t[0] + t[1]) * (1.0f / 128.0f) + NORM_EPS); }
                bf16_t* rowp = mkv + (size_t)(rbase + ai * 128 + m * 16) * MKV_N + u.pn * 256 + wc * 64 + 8 * fq;
#pragma unroll
                for (int bj = 0; bj < 2; ++bj) { const f32x4 a = acc[ai][bj][m][0] * sc * gv[bj][0], b = acc[ai][bj][m][1] * sc * gv[bj][1]; u32x4 w; w.x = cvtpk(a[0], a[1]); w.y = cvtpk(a[2], a[3]); w.z = cvtpk(b[0], b[1]); w.w = cvtpk(b[2], b[3]);
                    *(u32x4*)(rowp + 32 * bj) = w; } }
    }
};

struct EpiOut {
    static constexpr int MODE = 1; static constexpr bool SIGNAL = false;
    const float* x; bf16_t* x1;
    __device__ __forceinline__ void operator()(const Acc& acc, const Unit& u, int wr, int wc, int fr, int fq, LAS unsigned char*) const {
        const int col0 = u.pn * 256 + wc * 32 + 8 * fq;
#pragma unroll
        for (int ai = 0; ai < 2; ++ai) {
            f32x4 res[4][2][2];
#pragma unroll
            for (int m = 0; m < 4; ++m) { const size_t off = (size_t)(u.pm * 256 + ai * 128 + wr * 64 + m * 16 + fr) * DM + col0;
#pragma unroll
                for (int bj = 0; bj < 2; ++bj)
#pragma unroll
                    for (int n = 0; n < 2; ++n) res[m][bj][n] = *(const f32x4*)(x + off + bj * 128 + n * 4); }
#pragma unroll
            for (int m = 0; m < 4; ++m) { const size_t off = (size_t)(u.pm * 256 + ai * 128 + wr * 64 + m * 16 + fr) * DM + col0;
#pragma unroll
                for (int bj = 0; bj < 2; ++bj) { const f32x4 a = res[m][bj][0] + acc[ai][bj][m][0], b = res[m][bj][1] + acc[ai][bj][m][1];
                    u32x4 w; w.x = cvtpk(a[0], a[1]); w.y = cvtpk(a[2], a[3]); w.z = cvtpk(b[0], b[1]); w.w = cvtpk(b[2], b[3]);
                    *(u32x4*)(x1 + off + bj * 128) = w; } }
        }
    }
};

struct EpiSwiglu {
    static constexpr int MODE = 1; static constexpr bool SIGNAL = true;
    bf16_t* he; unsigned* done;
    __device__ __forceinline__ int sig_chunk(const Unit& u) const { return u.pm; }
    __device__ __forceinline__ void operator()(const Acc& acc, const Unit& u, int wr, int wc, int fr, int fq, LAS unsigned char*) const {
        const int voff = (fr * DEXP + 8 * fq) * 2;
#pragma unroll
        for (int ai = 0; ai < 2; ++ai)
#pragma unroll
            for (int m = 0; m < 4; ++m) { const int soff = __builtin_amdgcn_readfirstlane(((u.pm * 256 + ai * 128 + wr * 64 + m * 16) * DEXP + u.pn * 128 + wc * 32) * 2);
                f32x4 h[2];
#pragma unroll
                for (int n = 0; n < 2; ++n) { const f32x4 a = acc[ai][0][m][n], b = acc[ai][1][m][n];
#pragma unroll
                    for (int e = 0; e < 4; ++e) h[n][e] = a[e] * sigmoidf_fast(a[e]) * b[e]; }
                u32x4 w; w.x = cvtpk(h[0][0], h[0][1]); w.y = cvtpk(h[0][2], h[0][3]); w.z = cvtpk(h[1][0], h[1][1]); w.w = cvtpk(h[1][2], h[1][3]);
                st16_wt((char*)he + (size_t)(unsigned)soff + voff, w); }
    }
};

struct EpiDown {
    static constexpr int MODE = 1; static constexpr bool SIGNAL = false;
    bf16_t* y; const int* row_slot; const float* row_w;
    __device__ __forceinline__ void operator()(const Acc& acc, const Unit& u, int wr, int wc, int fr, int fq, LAS unsigned char*) const {
        int slots[2][4]; float wgts[2][4];
#pragma unroll
        for (int ai = 0; ai < 2; ++ai)
#pragma unroll
            for (int m = 0; m < 4; ++m) { const int prow = u.pm * 256 + ai * 128 + wr * 64 + m * 16 + fr; slots[ai][m] = row_slot[prow]; wgts[ai][m] = row_w[prow]; }
#pragma unroll
        for (int ai = 0; ai < 2; ++ai)
#pragma unroll
            for (int m = 0; m < 4; ++m) { const int slot = slots[ai][m]; const float wgt = wgts[ai][m];
                if (slot >= 0) { bf16_t* rowp = y + (size_t)slot * DM + u.pn * 256 + wc * 32 + 8 * fq;
#pragma unroll
                    for (int bj = 0; bj < 2; ++bj) { const f32x4 a = acc[ai][bj][m][0] * wgt, b = acc[ai][bj][m][1] * wgt; u32x4 w; w.x = cvtpk(a[0], a[1]); w.y = cvtpk(a[2], a[3]); w.z = cvtpk(b[0], b[1]); w.w = cvtpk(b[2], b[3]);
                        *(u32x4*)(rowp + 128 * bj) = w; } } }
    }
};
}

namespace att {
#define SBAR() __builtin_amdgcn_sched_barrier(0)
typedef LAS const char* lds_cptr;
typedef short v4i16_t __attribute__((ext_vector_type(4)));
constexpr int SLOT_DA = 32768, SLOT_ML = 40960;
constexpr float THRL = 8.0f;
__device__ __forceinline__ int crow(int r, int hi) { return (r & 3) + 8 * (r >> 2) + 4 * hi; }
__device__ __forceinline__ void glds16(const void* gsrc, unsigned lds_dst) { unsigned keep;
    asm volatile("s_mov_b32 %0, m0\n\ts_mov_b32 m0, %2\n\ts_nop 0\n\tglobal_load_lds_dwordx4 %1, off\n\ts_mov_b32 m0, %0" : "=&s"(keep) : "v"(gsrc), "s"(lds_dst) : "memory"); }
__device__ __forceinline__ s16x4 vtr(lds_cptr p) { return __builtin_bit_cast(s16x4, __builtin_amdgcn_ds_read_tr16_b64_v4i16((LAS v4i16_t*)p)); }
__device__ __forceinline__ float swap_max(float v) { auto rr = __builtin_amdgcn_permlane32_swap(__float_as_uint(v), __float_as_uint(v), false, false); return fmaxf(__uint_as_float(rr[0]), __uint_as_float(rr[1])); }
__device__ __forceinline__ float swap_add(float v) { auto rr = __builtin_amdgcn_permlane32_swap(__float_as_uint(v), __float_as_uint(v), false, false); return __uint_as_float(rr[0]) + __uint_as_float(rr[1]); }
#define WAIT_BAR(N) asm volatile("s_waitcnt vmcnt(" #N ") lgkmcnt(0)\n\ts_barrier" ::: "memory")

template <int NQF>
__device__ __forceinline__ void qk_softmax(const bf16x8 (&qf)[NQF], unsigned ka, unsigned kr, f32x16 (&o)[4], f32x16& negm, float& m_run, float& l_run, bool& first, LAS float* wsf,
                                           int r32, int hi, bool need_mask, int qg, int k0, int var, u32x4 (&pw)[4]) {
    f32x16 p0, p1;
#define KLD(dst, d0_) do { const unsigned a_ = ((d0_) < 8) ? (ka ^ (unsigned)((d0_) << 5)) : (kr ^ (unsigned)(((d0_) - 8) << 5)); \
        dst[0] = *(const LAS bf16x8*)(uintptr_t)a_; dst[1] = *(const LAS bf16x8*)(uintptr_t)(a_ + ((d0_) < 8 ? 8192u : 4096u)); } while (0)
#if PROBE_VARIANTS
    if (var & 4) { p0 = negm; p1 = negm; asm volatile("" : "+v"(p0), "+v"(p1)); } else
#endif
    if constexpr (NQF == 4) {
        bf16x8 kf[4][2];
#pragma unroll
        for (int d0 = 0; d0 < 4; ++d0) KLD(kf[d0], d0);
        SBAR();
        __builtin_amdgcn_s_setprio(1);
        p0 = __builtin_amdgcn_mfma_f32_32x32x16_bf16(kf[0][0], qf[0], negm, 0, 0, 0); p1 = __builtin_amdgcn_mfma_f32_32x32x16_bf16(kf[0][1], qf[0], negm, 0, 0, 0);
#pragma unroll
        for (int d0 = 1; d0 < 4; ++d0) { p0 = __builtin_amdgcn_mfma_f32_32x32x16_bf16(kf[d0][0], qf[d0], p0, 0, 0, 0); p1 = __builtin_amdgcn_mfma_f32_32x32x16_bf16(kf[d0][1], qf[d0], p1, 0, 0, 0); }
        __builtin_amdgcn_s_setprio(0);
    } else {
        bf16x8 kA[2][2], kB[2][2];
        KLD(kA[0], 0); KLD(kA[1], 1); SBAR();
#pragma unroll
        for (int g = 0; g < NQF / 2; g += 2) {
            if (g + 1 < NQF / 2) { KLD(kB[0], 2 * g + 2); KLD(kB[1], 2 * g + 3); } SBAR();
            if (g == 0) { p0 = __builtin_amdgcn_mfma_f32_32x32x16_bf16(kA[0][0], qf[0], negm, 0, 0, 0); p1 = __builtin_amdgcn_mfma_f32_32x32x16_bf16(kA[0][1], qf[0], negm, 0, 0, 0); }
            else { p0 = __builtin_amdgcn_mfma_f32_32x32x16_bf16(kA[0][0], qf[2 * g], p0, 0, 0, 0); p1 = __builtin_amdgcn_mfma_f32_32x32x16_bf16(kA[0][1], qf[2 * g], p1, 0, 0, 0); }
            p0 = __builtin_amdgcn_mfma_f32_32x32x16_bf16(kA[1][0], qf[2 * g + 1], p0, 0, 0, 0); p1 = __builtin_amdgcn_mfma_f32_32x32x16_bf16(kA[1][1], qf[2 * g + 1], p1, 0, 0, 0);
            SBAR();
            if (g + 1 < NQF / 2) {
                if (g + 2 < NQF / 2) { KLD(kA[0], 2 * g + 4); KLD(kA[1], 2 * g + 5); } SBAR();
                p0 = __builtin_amdgcn_mfma_f32_32x32x16_bf16(kB[0][0], qf[2 * g + 2], p0, 0, 0, 0); p1 = __builtin_amdgcn_mfma_f32_32x32x16_bf16(kB[0][1], qf[2 * g + 2], p1, 0, 0, 0);
                p0 = __builtin_amdgcn_mfma_f32_32x32x16_bf16(kB[1][0], qf[2 * g + 3], p0, 0, 0, 0); p1 = __builtin_amdgcn_mfma_f32_32x32x16_bf16(kB[1][1], qf[2 * g + 3], p1, 0, 0, 0);
                SBAR();
            }
        }
    }
#undef KLD
#if PROBE_VARIANTS
    if (!(var & 2))
#endif
    {
    if (need_mask) {
        const float NEG = -__builtin_inff(); const int kb = k0 + 4 * hi;
#pragma unroll
        for (int r = 0; r < 16; ++r) { const int kv = kb + (r & 3) + 8 * (r >> 2); if (kv > qg) p0[r] = NEG; if (kv + 32 > qg) p1[r] = NEG; }
    }
#pragma unroll
    for (int r = 0; r < 16; ++r) { __builtin_assume(p0[r] == p0[r]); __builtin_assume(p1[r] == p1[r]); }
    float mxa = __builtin_fmaxf(__builtin_fmaxf(p0[0], p0[1]), p1[0]), mxb = __builtin_fmaxf(__builtin_fmaxf(p0[2], p0[3]), p1[1]);
    mxa = __builtin_fmaxf(__builtin_fmaxf(mxa, p1[2]), p1[3]);
#pragma unroll
    for (int r = 4; r < 16; r += 4) { mxa = __builtin_fmaxf(__builtin_fmaxf(mxa, p0[r]), p0[r + 1]); mxb = __builtin_fmaxf(__builtin_fmaxf(mxb, p0[r + 2]), p0[r + 3]);
        mxa = __builtin_fmaxf(__builtin_fmaxf(mxa, p1[r]), p1[r + 1]); mxb = __builtin_fmaxf(__builtin_fmaxf(mxb, p1[r + 2]), p1[r + 3]); }
    float mx = swap_max(__builtin_fmaxf(mxa, mxb));
    if (__any(first || mx > THRL)) {
        const float dl = first ? mx : __builtin_fmaxf(mx, 0.f);
        m_run += dl;
#pragma unroll
        for (int r = 0; r < 16; ++r) { p0[r] -= dl; p1[r] -= dl; }
#pragma unroll
        for (int r = 0; r < 16; ++r) negm[r] = -m_run;
        if (!first) {
            const float alpha = __builtin_amdgcn_exp2f(-dl); l_run *= alpha;
            if (hi == 0) wsf[r32] = alpha;
#pragma unroll
            for (int g = 0; g < 4; ++g) { const f32x4 a4 = *(const LAS f32x4*)(wsf + 8 * g + 4 * hi);
#pragma unroll
                for (int d = 0; d < 4; ++d)
#pragma unroll
                    for (int e = 0; e < 4; ++e) o[d][4 * g + e] *= a4[e]; }
        }
        first = false;
    }
    float ps = 0.f;
#pragma unroll
    for (int r = 0; r < 16; ++r) { p0[r] = __builtin_amdgcn_exp2f(p0[r]); p1[r] = __builtin_amdgcn_exp2f(p1[r]); ps += p0[r] + p1[r]; }
    l_run += ps;
    }
    pw[0].x = cvtpk(p0[0], p0[1]); pw[0].y = cvtpk(p0[2], p0[3]); pw[0].z = cvtpk(p0[4], p0[5]); pw[0].w = cvtpk(p0[6], p0[7]);
    pw[1].x = cvtpk(p0[8], p0[9]); pw[1].y = cvtpk(p0[10], p0[11]); pw[1].z = cvtpk(p0[12], p0[13]); pw[1].w = cvtpk(p0[14], p0[15]);
    pw[2].x = cvtpk(p1[0], p1[1]); pw[2].y = cvtpk(p1[2], p1[3]); pw[2].z = cvtpk(p1[4], p1[5]); pw[2].w = cvtpk(p1[6], p1[7]);
    pw[3].x = cvtpk(p1[8], p1[9]); pw[3].y = cvtpk(p1[10], p1[11]); pw[3].z = cvtpk(p1[12], p1[13]); pw[3].w = cvtpk(p1[14], p1[15]);
}

__device__ __forceinline__ void pv_tile(const u32x4 (&pw)[4], unsigned va, f32x16 (&o)[4], int var) {
    const bf16x8 pa0 = __builtin_bit_cast(bf16x8, pw[0]), pa1 = __builtin_bit_cast(bf16x8, pw[1]), pa2 = __builtin_bit_cast(bf16x8, pw[2]), pa3 = __builtin_bit_cast(bf16x8, pw[3]);
#if PROBE_VARIANTS
    if (var & 8) { asm volatile("" :: "v"(pa0), "v"(pa1), "v"(pa2), "v"(pa3)); return; }
#endif
    s16x4 loA[4], hhA[4], loB[4], hhB[4];
#define VLD(L, H, d_) do { const lds_cptr vp_ = (lds_cptr)(uintptr_t)(va ^ (unsigned)((d_) << 6)); \
        _Pragma("unroll") for (int ks = 0; ks < 4; ++ks) { L[ks] = vtr(vp_ + ks * 4096); H[ks] = vtr(vp_ + ks * 4096 + 2048); } } while (0)
#define PKV(L, H, k) (bf16x8){L[k][0], L[k][1], L[k][2], L[k][3], H[k][0], H[k][1], H[k][2], H[k][3]}
#define PVMM(L, H, d_) do { __builtin_amdgcn_s_setprio(1); o[d_] = __builtin_amdgcn_mfma_f32_32x32x16_bf16(pa0, PKV(L, H, 0), o[d_], 0, 0, 0); o[d_] = __builtin_amdgcn_mfma_f32_32x32x16_bf16(pa1, PKV(L, H, 1), o[d_], 0, 0, 0); \
        o[d_] = __builtin_amdgcn_mfma_f32_32x32x16_bf16(pa2, PKV(L, H, 2), o[d_], 0, 0, 0); o[d_] = __builtin_amdgcn_mfma_f32_32x32x16_bf16(pa3, PKV(L, H, 3), o[d_], 0, 0, 0); __builtin_amdgcn_s_setprio(0); } while (0)
    VLD(loA, hhA, 0);
    SBAR(); VLD(loB, hhB, 1); SBAR(); PVMM(loA, hhA, 0);
    SBAR(); VLD(loA, hhA, 2); SBAR(); PVMM(loB, hhB, 1);
    SBAR(); VLD(loB, hhB, 3); SBAR(); PVMM(loA, hhA, 2);
    SBAR(); PVMM(loB, hhB, 3);
#undef PVMM
#undef PKV
#undef VLD
}

struct AttnP { const bf16_t *daq, *dak, *dav, *mq, *mkv, *krope; const unsigned char* gates; bf16_t* mixed; const float *subln_g, *mla_qg, *rope_ml; float lam; bool dry; int var; };

__device__ __forceinline__ void stage_o(f32x16 (&o)[4], float l_run, LAS float* wsf, LAS float* stg, int r32, int hi) {
    const float linv = 1.0f / swap_add(l_run);
    if (hi == 0) wsf[r32] = linv;
#pragma unroll
    for (int g = 0; g < 4; ++g) { const f32x4 a4 = *(const LAS f32x4*)(wsf + 8 * g + 4 * hi);
#pragma unroll
        for (int d = 0; d < 4; ++d)
#pragma unroll
            for (int e = 0; e < 4; ++e) stg[(8 * g + 4 * hi + e) * STAGE_ROW + 32 * d + r32] = o[d][4 * g + e] * a4[e]; }
}

__device__ __forceinline__ void da_sub(const AttnP& P, int b, int h, int q0, bool swapmaps, char* shm) {
    int tid_ = threadIdx.x; asm volatile("" : "+v"(tid_));
    const int tid = tid_, lane = tid & 63, r32 = lane & 31, hi = lane >> 5; const int wid = __builtin_amdgcn_readfirstlane(tid >> 6);
    const int map = swapmaps ? 1 - (wid >> 2) : (wid >> 2);
    const int qw = q0 + 32 * (wid & 3);
    const size_t tok0 = (size_t)b * SEQ;
    const unsigned lds0 = (unsigned)(uintptr_t)shm;
    const lds_cptr shm3 = (lds_cptr)shm;
    LAS float* wsf = (LAS float*)(shm3 + WSF_OFF) + wid * 64;
    const int NT = (q0 + 128) / 64;
    const int dkey = 4 * wid + (lane >> 4), dpos = lane & 15;
    const bf16_t* ksrc = P.dak + (tok0 + dkey) * 1024 + h * 128 + ((dpos ^ (dkey & 15)) << 3);
    const bf16_t* vsrc = P.dav + (tok0 + dkey) * 1024 + h * 128 + ((dpos ^ ((dkey & 3) << 2)) << 3);
#define DMA_TILE(t, ks_, vs_) do { const unsigned k_ = (unsigned)__builtin_amdgcn_readfirstlane(lds0 + (ks_)), v_ = (unsigned)__builtin_amdgcn_readfirstlane(lds0 + (vs_)); const size_t ro_ = (size_t)(t) * 64 * 1024; \
        glds16(ksrc + ro_, k_ + wid * 1024); glds16(ksrc + ro_ + 32 * 1024, k_ + (wid + 8) * 1024); \
        glds16(vsrc + ro_, v_ + wid * 1024); glds16(vsrc + ro_ + 32 * 1024, v_ + (wid + 8) * 1024); } while (0)
    constexpr int KR0 = 0, KSZ = 16384, VR0 = 49152, VSZ = 16384;
    DMA_TILE(0, KR0, VR0); DMA_TILE(1, KR0 + KSZ, VR0 + VSZ);
    bf16x8 qf[4];
    { const bf16_t* qp = P.daq + (tok0 + qw + r32) * 1024 + h * 128 + 64 * map + 8 * hi;
#pragma unroll
      for (int d0 = 0; d0 < 4; ++d0) qf[d0] = *(const bf16x8*)(qp + 16 * d0); }
    f32x16 o[4]; o[0] = f32x16{}; o[1] = f32x16{}; o[2] = f32x16{}; o[3] = f32x16{};
    float m_run = 0.f, l_run = 0.f; bool first = true; f32x16 negm = f32x16{};
    const unsigned koff = (unsigned)(r32 * 256 + (((8 * map + hi) ^ (r32 & 15)) << 4));
    const int vq = (lane & 15) >> 2;
    const unsigned voff = (unsigned)((4 * hi + vq) * 256 + (vq << 6) + ((((lane >> 4) & 1) * 2 + ((lane & 3) >> 1)) << 4) + ((lane & 1) << 3));
    const int qg = qw + r32;
    const bool defer = wid >= 4;
    u32x4 pw[4]; bool pend = false; unsigned va_pend = 0;
    int kc = KR0, kn = KR0 + KSZ, knn = KR0 + 2 * KSZ;
    int vc = VR0, vnn = VR0 + 2 * VSZ;
    for (int t = 0; t < NT; ++t) {
#if PROBE_VARIANTS
        if (P.var & 16) { asm volatile("s_waitcnt vmcnt(0) lgkmcnt(0)" ::: "memory"); } else
#endif
        { if (t + 1 < NT) WAIT_BAR(4); else WAIT_BAR(0); }
        if (t + 2 < NT && !(PROBE_VARIANTS && (P.var & 1))) DMA_TILE(t + 2, knn, vnn);
        if (pend) { pv_tile(pw, va_pend, o, P.var); pend = false; }
        if (64 * t <= qw + 31) {
            qk_softmax<4>(qf, lds0 + kc + koff, 0u, o, negm, m_run, l_run, first, wsf, r32, hi, 64 * t + 63 > qw, qg, 64 * t, P.var, pw);
            if (defer) { pend = true; va_pend = lds0 + vc + voff; } else pv_tile(pw, lds0 + vc + voff, o, P.var);
        }
        { const int tmp = kc; kc = kn; kn = knn; knn = tmp; }
        vc = (vc == VR0 + 3 * VSZ) ? VR0 : vc + VSZ; vnn = (vnn == VR0 + 3 * VSZ) ? VR0 : vnn + VSZ;
    }
    if (pend) pv_tile(pw, va_pend, o, P.var);
#undef DMA_TILE
    WAIT_BAR(0);
    LAS float* stg = (LAS float*)shm3 + wid * (OSTG_BYTES / 4);
    stage_o(o, l_run, wsf, stg, r32, hi);
    WAIT_BAR(0);
    if (map == 0) {
        const LAS float* sp = (const LAS float*)shm3 + (wid ^ 4) * (OSTG_BYTES / 4);
        const int row = lane & 31, half = lane >> 5;
        f32x4 dv[16]; float ss = 0.f;
#pragma unroll
        for (int i = 0; i < 16; ++i) { const f32x4 a = *(const LAS f32x4*)(stg + row * STAGE_ROW + 64 * half + 4 * i), c = *(const LAS f32x4*)(sp + row * STAGE_ROW + 64 * half + 4 * i);
            dv[i] = a - c * P.lam; ss += (dv[i][0] * dv[i][0] + dv[i][1] * dv[i][1]) + (dv[i][2] * dv[i][2] + dv[i][3] * dv[i][3]); }
        ss += __shfl_xor(ss, 32);
        const float rinv = __builtin_amdgcn_rsqf(ss * (1.0f / 128.0f) + NORM_EPS) * ((1.0f - LAMBDA_INIT) / 255.0f);
        const size_t tok = tok0 + qw + row;
        const unsigned char* gp = P.gates + tok * 2048 + h * 128 + 64 * half; bf16_t* op = P.mixed + tok * 1024 + h * 128 + 64 * half; const float* sg = P.subln_g + 64 * half;
        u32x4 gwv[4]; f32x4 sgv[16];
#pragma unroll
        for (int i = 0; i < 4; ++i) gwv[i] = *(const u32x4*)(gp + 16 * i);
#pragma unroll
        for (int i = 0; i < 8; ++i) { sgv[2 * i] = *(const f32x4*)(sg + 8 * i); sgv[2 * i + 1] = *(const f32x4*)(sg + 8 * i + 4); }
#pragma unroll
        for (int i = 0; i < 8; ++i) { const unsigned ga = gwv[i >> 1][2 * (i & 1)], gc = gwv[i >> 1][2 * (i & 1) + 1]; const f32x4 g0 = sgv[2 * i], g1 = sgv[2 * i + 1];
            const f32x4 a = dv[2 * i] * g0 * rinv, c = dv[2 * i + 1] * g1 * rinv; u32x4 w;
            w.x = cvtpk(a[0] * UB(ga, 0), a[1] * UB(ga, 1)); w.y = cvtpk(a[2] * UB(ga, 2), a[3] * UB(ga, 3));
            w.z = cvtpk(c[0] * UB(gc, 0), c[1] * UB(gc, 1)); w.w = cvtpk(c[2] * UB(gc, 2), c[3] * UB(gc, 3));
            if (!P.dry) *(u32x4*)(op + 8 * i) = w; }
    }
    WAIT_BAR(0);
}

__device__ __forceinline__ void mla_unit(const AttnP& P, int b, int h, int q0, char* shm) {
    int tid_ = threadIdx.x; asm volatile("" : "+v"(tid_));
    const int tid = tid_, lane = tid & 63, r32 = lane & 31, hi = lane >> 5; const int wid = __builtin_amdgcn_readfirstlane(tid >> 6);
    const int qw = q0 + 32 * wid;
    const size_t tok0 = (size_t)b * SEQ;
    const unsigned lds0 = (unsigned)(uintptr_t)shm;
    const lds_cptr shm3 = (lds_cptr)shm;
    LAS float* wsf = (LAS float*)(shm3 + WSF_OFF) + wid * 64;
    const int NT = (q0 + 256) / 64;
    const int dkey = 4 * wid + (lane >> 4), dpos = lane & 15, rkey = 8 * wid + (lane >> 3);
    const bf16_t* ksrc = P.mkv + (tok0 + dkey) * 2048 + h * 256 + ((dpos ^ (dkey & 15)) << 3);
    const bf16_t* vsrc = P.mkv + (tok0 + dkey) * 2048 + h * 256 + 128 + ((dpos ^ ((dkey & 3) << 2)) << 3);
    const bf16_t* rsrc = P.krope + (tok0 + rkey) * 64 + (((lane & 7) ^ ((rkey >> 1) & 7)) << 3);
#define DMA_TILE(t, ks_, vs_) do { const unsigned k_ = (unsigned)__builtin_amdgcn_readfirstlane(lds0 + (ks_)), v_ = (unsigned)__builtin_amdgcn_readfirstlane(lds0 + (vs_)); const size_t ro_ = (size_t)(t) * 64 * 2048; \
        glds16(ksrc + ro_, k_ + wid * 1024); glds16(ksrc + ro_ + 32 * 2048, k_ + (wid + 8) * 1024); glds16(rsrc + (size_t)(t) * 64 * 64, k_ + 16384 + wid * 1024); \
        glds16(vsrc + ro_, v_ + wid * 1024); glds16(vsrc + ro_ + 32 * 2048, v_ + (wid + 8) * 1024); } while (0)
    constexpr int KR0 = 0, KSZ = 24576, VR0 = 73728, VSZ = 16384;
    DMA_TILE(0, KR0, VR0); DMA_TILE(1, KR0 + KSZ, VR0 + VSZ);
    bf16x8 qf[12];
    { const size_t tok = tok0 + qw + r32; const bf16_t* qp = P.mq + tok * MQ_N + h * 192 + 8 * hi;
      u32x4 raw[12]; float ss = 0.f;
#pragma unroll
      for (int d0 = 0; d0 < 12; ++d0) { raw[d0] = *(const u32x4*)(qp + 16 * d0);
#pragma unroll
          for (int j = 0; j < 4; ++j) { const float a = bf_lo(raw[d0][j]), c = bf_hi(raw[d0][j]); ss += a * a + c * c; } }
      ss += __shfl_xor(ss, 32);
      const float rinv = __builtin_amdgcn_rsqf(ss * (1.0f / 192.0f) + NORM_EPS) * C2_MLA;
      const float* gq = P.mla_qg + 8 * hi; const float* rt = P.rope_ml + tok * 64 + 8 * hi;
#pragma unroll
      for (int d0 = 0; d0 < 8; ++d0) { const f32x4 g0 = *(const f32x4*)(gq + 16 * d0), g1 = *(const f32x4*)(gq + 16 * d0 + 4); u32x4 w;
          w.x = cvtpk(bf_lo(raw[d0].x) * g0[0] * rinv, bf_hi(raw[d0].x) * g0[1] * rinv); w.y = cvtpk(bf_lo(raw[d0].y) * g0[2] * rinv, bf_hi(raw[d0].y) * g0[3] * rinv);
          w.z = cvtpk(bf_lo(raw[d0].z) * g1[0] * rinv, bf_hi(raw[d0].z) * g1[1] * rinv); w.w = cvtpk(bf_lo(raw[d0].w) * g1[2] * rinv, bf_hi(raw[d0].w) * g1[3] * rinv);
          qf[d0] = __builtin_bit_cast(bf16x8, w); }
#pragma unroll
      for (int dd = 0; dd < 2; ++dd) {
          float x1[8], x2[8], c[8], s[8];
          const f32x4 ga0 = *(const f32x4*)(gq + 16 * (8 + dd)), ga1 = *(const f32x4*)(gq + 16 * (8 + dd) + 4), gb0 = *(const f32x4*)(gq + 16 * (10 + dd)), gb1 = *(const f32x4*)(gq + 16 * (10 + dd) + 4);
          const f32x4 c0 = *(const f32x4*)(rt + 16 * dd), c1 = *(const f32x4*)(rt + 16 * dd + 4), s0 = *(const f32x4*)(rt + 32 + 16 * dd), s1 = *(const f32x4*)(rt + 32 + 16 * dd + 4);
#pragma unroll
          for (int j = 0; j < 4; ++j) { x1[2 * j] = bf_lo(raw[8 + dd][j]); x1[2 * j + 1] = bf_hi(raw[8 + dd][j]); x2[2 * j] = bf_lo(raw[10 + dd][j]); x2[2 * j + 1] = bf_hi(raw[10 + dd][j]); }
#pragma unroll
          for (int j = 0; j < 4; ++j) { c[j] = c0[j]; c[4 + j] = c1[j]; s[j] = s0[j]; s[4 + j] = s1[j];
              x1[j] *= ga0[j] * rinv; x1[4 + j] *= ga1[j] * rinv; x2[j] *= gb0[j] * rinv; x2[4 + j] *= gb1[j] * rinv; }
          float y1[8], y2[8];
#pragma unroll
          for (int j = 0; j < 8; ++j) { y1[j] = x1[j] * c[j] - x2[j] * s[j]; y2[j] = x2[j] * c[j] + x1[j] * s[j]; }
          u32x4 w; w.x = cvtpk(y1[0], y1[1]); w.y = cvtpk(y1[2], y1[3]); w.z = cvtpk(y1[4], y1[5]); w.w = cvtpk(y1[6], y1[7]); qf[8 + dd] = __builtin_bit_cast(bf16x8, w);
          w.x = cvtpk(y2[0], y2[1]); w.y = cvtpk(y2[2], y2[3]); w.z = cvtpk(y2[4], y2[5]); w.w = cvtpk(y2[6], y2[7]); qf[10 + dd] = __builtin_bit_cast(bf16x8, w);
      }
    }
    f32x16 o[4]; o[0] = f32x16{}; o[1] = f32x16{}; o[2] = f32x16{}; o[3] = f32x16{};
    float m_run = 0.f, l_run = 0.f; bool first = true; f32x16 negm = f32x16{};
    const unsigned koff = (unsigned)(r32 * 256 + ((hi ^ (r32 & 15)) << 4));
    const unsigned roff = 16384u + (unsigned)(r32 * 128 + ((hi ^ ((r32 >> 1) & 7)) << 4));
    const int vq = (lane & 15) >> 2;
    const unsigned voff = (unsigned)((4 * hi + vq) * 256 + (vq << 6) + ((((lane >> 4) & 1) * 2 + ((lane & 3) >> 1)) << 4) + ((lane & 1) << 3));
    const int qg = qw + r32;
    const bool defer = wid >= 4;
    u32x4 pw[4]; bool pend = false; unsigned va_pend = 0;
    int kc = KR0, kn = KR0 + KSZ, knn = KR0 + 2 * KSZ;
    int vc = VR0, vnn = VR0 + 2 * VSZ;
    for (int t = 0; t < NT; ++t) {
#if PROBE_VARIANTS
        if (P.var & 16) { asm volatile("s_waitcnt vmcnt(0) lgkmcnt(0)" ::: "memory"); } else
#endif
        { if (t + 1 < NT) WAIT_BAR(5); else WAIT_BAR(0); }
        if (t + 2 < NT && !(PROBE_VARIANTS && (P.var & 1))) DMA_TILE(t + 2, knn, vnn);
        if (pend) { pv_tile(pw, va_pend, o, P.var); pend = false; }
        if (64 * t <= qw + 31) {
            qk_softmax<12>(qf, lds0 + kc + koff, lds0 + kc + roff, o, negm, m_run, l_run, first, wsf, r32, hi, 64 * t + 63 > qw, qg, 64 * t, P.var, pw);
            if (defer) { pend = true; va_pend = lds0 + vc + voff; } else pv_tile(pw, lds0 + vc + voff, o, P.var);
        }
        { const int tmp = kc; kc = kn; kn = knn; knn = tmp; }
        vc = (vc == VR0 + 3 * VSZ) ? VR0 : vc + VSZ; vnn = (vnn == VR0 + 3 * VSZ) ? VR0 : vnn + VSZ;
    }
    if (pend) pv_tile(pw, va_pend, o, P.var);
#undef DMA_TILE
    WAIT_BAR(0);
    LAS float* stg = (LAS float*)shm3 + wid * (OSTG_BYTES / 4);
    stage_o(o, l_run, wsf, stg, r32, hi);
    LDS_WAIT();
    {
        const int row = lane & 31, half = lane >> 5; const size_t tok = tok0 + qw + row;
        const unsigned char* gp = P.gates + tok * 2048 + 1024 + h * 128 + 64 * half; bf16_t* op = P.mixed + tok * 1024 + h * 128 + 64 * half;
        u32x4 gwv[4]; unsigned long long st0[8], st1[8];
#pragma unroll
        for (int i = 0; i < 4; ++i) gwv[i] = *(const u32x4*)(gp + 16 * i);
#pragma unroll
        for (int i = 0; i < 8; ++i) {
            st0[i] = __hip_atomic_load((const unsigned long long*)(op + 8 * i), __ATOMIC_RELAXED, __HIP_MEMORY_SCOPE_AGENT);
            st1[i] = __hip_atomic_load((const unsigned long long*)(op + 8 * i + 4), __ATOMIC_RELAXED, __HIP_MEMORY_SCOPE_AGENT); }
#pragma unroll
        for (int i = 0; i < 8; ++i) { const unsigned ga = gwv[i >> 1][2 * (i & 1)], gc = gwv[i >> 1][2 * (i & 1) + 1];
            const unsigned long long s0 = st0[i];
            const unsigned long long s1 = st1[i];
            const unsigned sx = (unsigned)s0, sy = (unsigned)(s0 >> 32), sz = (unsigned)s1, sw = (unsigned)(s1 >> 32);
            const f32x4 a = *(const LAS f32x4*)(stg + row * STAGE_ROW + 64 * half + 8 * i) * (1.0f / 255.0f), c = *(const LAS f32x4*)(stg + row * STAGE_ROW + 64 * half + 8 * i + 4) * (1.0f / 255.0f); u32x4 w;
            w.x = cvtpk(a[0] * UB(ga, 0) + bf_lo(sx), a[1] * UB(ga, 1) + bf_hi(sx)); w.y = cvtpk(a[2] * UB(ga, 2) + bf_lo(sy), a[3] * UB(ga, 3) + bf_hi(sy));
            w.z = cvtpk(c[0] * UB(gc, 0) + bf_lo(sz), c[1] * UB(gc, 1) + bf_hi(sz)); w.w = cvtpk(c[2] * UB(gc, 2) + bf_lo(sw), c[3] * UB(gc, 3) + bf_hi(sw));
            if (!P.dry) *(u32x4*)(op + 8 * i) = w; }
    }
    WAIT_BAR(0);
}

__device__ __forceinline__ void attn_phase(const AttnP& P, int G, int vcu, char* shm) {
    for (int i = 0;; ++i) {
        const int L = i * G + vcu; if (L >= 1024) break;
        const int j = L >> 8, v = L & 255; const int bh = 32 * (j >> 1) + (v >> 3); const int qb = (j & 1) ? (v & 7) : 15 - (v & 7);
        const int b = bh >> 3, h = bh & 7;
        da_sub(P, b, h, qb * 256, false, shm);
        da_sub(P, b, h, qb * 256 + 128, true, shm);
        mla_unit(P, b, h, qb * 256, shm);
    }
}
#undef SBAR
#undef WAIT_BAR
}

constexpr int NWAVES = 8, NTHREADS = 512, NPHASE = 10;
struct Args { const void* in[28]; float* out; unsigned char* ws; int ph_lo, ph_hi, coop, rep_mask; };

__device__ __forceinline__ void transpose_item(const float* W, int N, int k0, int n0, bf16_t* WT, int ldk, int drow0, const float* kscale, LAS float* scr, int lane) {
#pragma unroll
    for (int i = 0; i < 32; ++i) { const int kk = 2 * i + (lane >> 5); float v = W[(size_t)(k0 + kk) * N + n0 + (lane & 31)]; if (kscale) v *= kscale[k0 + kk]; scr[kk * 33 + (lane & 31)] = v; }
    LDS_WAIT(); asm volatile("" ::: "memory");
    const int c = lane & 7;
#pragma unroll
    for (int j = 0; j < 4; ++j) { const int n = (lane >> 3) + 8 * j; const LAS float* s = scr + (8 * c) * 33 + n;
        u32x4 o; o.x = cvtpk(s[0 * 33], s[1 * 33]); o.y = cvtpk(s[2 * 33], s[3 * 33]); o.z = cvtpk(s[4 * 33], s[5 * 33]); o.w = cvtpk(s[6 * 33], s[7 * 33]);
        *(u32x4*)(WT + (size_t)(drow0 + n) * ldk + k0 + 8 * c) = o; }
    LDS_WAIT(); asm volatile("" ::: "memory");
}

__device__ __forceinline__ void ttb_load(f32x4 (&v)[8], const float* W, int N, int k0, int n0, int tid) {
    const int n4 = tid & 63, kr = tid >> 6;
#pragma unroll
    for (int p = 0; p < 8; ++p) v[p] = *(const f32x4*)(W + (size_t)(k0 + 8 * p + kr) * N + n0 + 4 * n4);
}
__device__ __forceinline__ void ttb_finish(const f32x4 (&v)[8], int k0, int n0, bf16_t* WT, int ldk, int is3, LAS float* T, int tid) {
    const int n4 = tid & 63, kr = tid >> 6;
#pragma unroll
    for (int p = 0; p < 8; ++p) *(LAS f32x4*)(T + (8 * p + kr) * 256 + 4 * (n4 ^ p)) = v[p];
    __syncthreads();
    const int c = tid & 7, nb = tid >> 3;
#pragma unroll
    for (int j = 0; j < 4; ++j) { const int n = nb + 64 * j; const LAS float* sp = T + (8 * c) * 256 + (n ^ (c << 2));
        u32x4 o; o.x = cvtpk(sp[0], sp[256]); o.y = cvtpk(sp[512], sp[768]); o.z = cvtpk(sp[1024], sp[1280]); o.w = cvtpk(sp[1536], sp[1792]);
        const int nn = n0 + n; const int drow = is3 < 0 ? nn : (256 * (nn >> 7) + 128 * is3 + (nn & 127));
        *(u32x4*)(WT + (size_t)drow * ldk + k0 + 8 * c) = o; }
    __syncthreads();
}

__device__ __forceinline__ void sincos_d(double a, float& s, float& c) {
    const double TWO_PI = 6.283185307179586, TWO_PI_LO = 2.4492935982947064e-16, HALF_PI = 1.5707963267948966;
    const double k = __builtin_rint(a * (1.0 / TWO_PI));
    double r = __builtin_fma(-k, TWO_PI, a); r = __builtin_fma(-k, TWO_PI_LO, r);
    const double q = __builtin_rint(r * (1.0 / HALF_PI)); const double y = __builtin_fma(-q, HALF_PI, r);
    const double y2 = y * y;
    double sp = -1.0 / 6227020800.0; sp = sp * y2 + 1.0 / 39916800.0; sp = sp * y2 - 1.0 / 362880.0; sp = sp * y2 + 1.0 / 5040.0; sp = sp * y2 - 1.0 / 120.0; sp = sp * y2 + 1.0 / 6.0; sp = y - y * y2 * sp;
    double cp = 1.0 / 479001600.0; cp = cp * y2 - 1.0 / 3628800.0; cp = cp * y2 + 1.0 / 40320.0; cp = cp * y2 - 1.0 / 720.0; cp = cp * y2 + 1.0 / 24.0; cp = cp * y2 - 0.5; cp = 1.0 + y2 * cp;
    const int qi = ((int)q) & 3;
    const double ss = (qi == 0) ? sp : (qi == 1) ? cp : (qi == 2) ? -sp : -cp;
    const double cc = (qi == 0) ? cp : (qi == 1) ? -sp : (qi == 2) ? -cp : sp;
    s = (float)ss; c = (float)cc;
}

#define DPPF(v_, CTRL_) __builtin_bit_cast(float, __builtin_amdgcn_update_dpp(__builtin_bit_cast(int, (v_)), __builtin_bit_cast(int, (v_)), (CTRL_), 0xF, 0xF, false))
__device__ __forceinline__ float rows_sum(float w) {
    w += DPPF(w, 0x124); w += DPPF(w, 0x128);
    { auto r = __builtin_amdgcn_permlane16_swap(__float_as_uint(w), __float_as_uint(w), false, false); w = __uint_as_float(r[0]) + __uint_as_float(r[1]); }
    { auto r = __builtin_amdgcn_permlane32_swap(__float_as_uint(w), __float_as_uint(w), false, false); w = __uint_as_float(r[0]) + __uint_as_float(r[1]); }
    return w;
}
__device__ __forceinline__ float red4(const float (&a)[4], bool b0, bool b1) {
    const float u0 = (b0 ? a[1] : a[0]) + DPPF(b0 ? a[0] : a[1], 0xB1), u1 = (b0 ? a[3] : a[2]) + DPPF(b0 ? a[2] : a[3], 0xB1);
    return rows_sum((b1 ? u1 : u0) + DPPF(b1 ? u0 : u1, 0x4E));
}
__device__ __forceinline__ void red8(const float (&a)[8], bool b0, bool b1, float& w0, float& w1) {
    float u[4];
#pragma unroll
    for (int i = 0; i < 4; ++i) u[i] = (b0 ? a[2 * i + 1] : a[2 * i]) + DPPF(b0 ? a[2 * i] : a[2 * i + 1], 0xB1);
    w0 = rows_sum((b1 ? u[1] : u[0]) + DPPF(b1 ? u[0] : u[1], 0x4E));
    w1 = rows_sum((b1 ? u[3] : u[2]) + DPPF(b1 ? u[2] : u[3], 0x4E));
}
#define RDLANE(v_, L_) __builtin_bit_cast(float, __builtin_amdgcn_readlane(__builtin_bit_cast(int, (v_)), (L_)))

#define XB_TMO      128
#define XB_XCNT(j)  (256  + 64 * (j))
#define XB_XSUB(j)  (1280 + 64 * (j))
#define XB_XGEN(j)  (2304 + 64 * (j))
#define XB_TOP      3328
#define XB_TOPGEN   3392
#define XCD_BAR_WORDS 3456
#define XB_SPIN_CAP (1u << 18)
__device__ __forceinline__ unsigned xb_ld(unsigned* p)              { return __hip_atomic_load(p, __ATOMIC_RELAXED, __HIP_MEMORY_SCOPE_AGENT); }
__device__ __forceinline__ unsigned xb_add(unsigned* p, unsigned v) { return __hip_atomic_fetch_add(p, v, __ATOMIC_RELAXED, __HIP_MEMORY_SCOPE_AGENT); }
__device__ __forceinline__ unsigned xb_xcc_id() { return (unsigned)__builtin_amdgcn_s_getreg((3 << 11) | 20) & 0xFu; }
#define XB_SPIN(cond, bar) do { unsigned _sp = 0; while (cond) { __builtin_amdgcn_s_sleep(1); \
    if ((++_sp & 255u) == 0u) { if (xb_ld(&(bar)[XB_TMO])) break; if (_sp > XB_SPIN_CAP) { atomicAdd(&(bar)[XB_TMO], 1u); break; } } } } while (0)
struct XcdBarrier { unsigned* bar; unsigned x; volatile LAS unsigned* st; };
__device__ __forceinline__ XcdBarrier xcd_barrier_post(unsigned* bar, volatile LAS unsigned* st) {
    XcdBarrier b; b.bar = bar; b.x = xb_xcc_id(); b.st = st;
    if (threadIdx.x == 0) (void)xb_add(&bar[XB_XCNT(b.x)], 1u);
    return b;
}
__device__ __forceinline__ void xcd_barrier_complete(unsigned* bar, unsigned x, unsigned& nloc, unsigned& nx) {
    const unsigned G = gridDim.x * gridDim.y * gridDim.z;
    unsigned sum, cnt, mine, sp = 0u;
    for (;;) {
        sum = 0u; cnt = 0u; mine = 0u;
#pragma unroll
        for (unsigned j = 0; j < 16; ++j) { const unsigned c = xb_ld(&bar[XB_XCNT(j)]); sum += c; cnt += (c > 0u) ? 1u : 0u; mine = (j == x) ? c : mine; }
        if (sum == G) break;
        __builtin_amdgcn_s_sleep(1);
        if ((++sp & 255u) == 0u) { if (xb_ld(&bar[XB_TMO])) break; if (sp > XB_SPIN_CAP) { atomicAdd(&bar[XB_TMO], 1u); break; } }
    }
    nloc = mine > 0u ? mine : 1u; nx = cnt > 0u ? cnt : 1u;
}
__device__ __forceinline__ void xcd_barrier(const XcdBarrier& b) {
    asm volatile("s_waitcnt vmcnt(0)" ::: "memory");
    __syncthreads();
    if (threadIdx.x == 0) {
        unsigned* bar = b.bar;
        __builtin_amdgcn_s_waitcnt(0);
        unsigned nloc = b.st[0], nx = b.st[1];
        if (nloc == 0u) { xcd_barrier_complete(bar, b.x, nloc, nx); b.st[0] = nloc; b.st[1] = nx; }
        const unsigned old = xb_add(&bar[XB_XSUB(b.x)], 1u);
        const unsigned gen = old / nloc;
        if (old + 1u == (gen + 1u) * nloc) {
            __builtin_amdgcn_fence(__ATOMIC_RELEASE, "agent");
            asm volatile("s_waitcnt vmcnt(0)" ::: "memory");
            const unsigned og = xb_add(&bar[XB_TOP], 1u);
            const unsigned tg = og / nx;
            if (og + 1u == (tg + 1u) * nx) xb_add(&bar[XB_TOPGEN], 1u);
            else XB_SPIN(xb_ld(&bar[XB_TOPGEN]) == tg, bar);
            __builtin_amdgcn_fence(__ATOMIC_ACQUIRE, "agent");
            xb_add(&bar[XB_XGEN(b.x)], 1u);
            asm volatile("s_waitcnt vmcnt(0)" ::: "memory");
        } else {
            XB_SPIN(xb_ld(&bar[XB_XGEN(b.x)]) == gen, bar);
            __builtin_amdgcn_fence(__ATOMIC_ACQUIRE, "agent");
            asm volatile("s_waitcnt vmcnt(0)" ::: "memory");
        }
    }
    __syncthreads();
}

__global__ void __launch_bounds__(NTHREADS, 2) hybrid_fwd(Args args) {
    extern __shared__ __attribute__((aligned(16))) unsigned char lds_raw[];
    LAS unsigned char* lds = (LAS unsigned char*)lds_raw;
    const int wave = __builtin_amdgcn_readfirstlane((int)threadIdx.x >> 6);
    const int G = gridDim.x, bx = blockIdx.x;
    const int vcu = (G % 8 == 0) ? (bx % 8) * (G / 8) + bx / 8 : bx;
    const int gw = vcu * NWAVES + wave, NGW = G * NWAVES;
    unsigned char* ws = args.ws;
    unsigned* ctl = (unsigned*)(ws + WS_CTL);
    const float* x = (const float*)args.in[0]; const int* positions = (const int*)args.in[1]; const float* attn_norm_g = (const float*)args.in[2];
    const float* w_in = (const float*)args.in[3]; const float* b_gate = (const float*)args.in[4]; const float* da_q_g = (const float*)args.in[5]; const float* da_k_g = (const float*)args.in[6];
    const float* lq1 = (const float*)args.in[7]; const float* lk1 = (const float*)args.in[8]; const float* lq2 = (const float*)args.in[9]; const float* lk2 = (const float*)args.in[10];
    const float* subln_g = (const float*)args.in[11]; const float* q_lora_g = (const float*)args.in[12]; const float* w_uq = (const float*)args.in[13];
    const float* kv_lora_g = (const float*)args.in[14]; const float* w_ukv = (const float*)args.in[15]; const float* mla_q_g = (const float*)args.in[16];
    const float* k_nope_g = (const float*)args.in[17]; const float* k_rope_g = (const float*)args.in[18]; const float* w_o = (const float*)args.in[19];
    const float* ffn_norm_g = (const float*)args.in[20]; const float* w_group = (const float*)args.in[21]; const float* b_group = (const float*)args.in[22];
    const float* w_router = (const float*)args.in[23]; const float* b_router = (const float*)args.in[24];
    const float* w1 = (const float*)args.in[25]; const float* w3 = (const float*)args.in[26]; const float* w2 = (const float*)args.in[27];
    float* out = args.out;
    float* rope_da = (float*)(ws + WS_ROPE_DA); float* rope_ml = (float*)(ws + WS_ROPE_ML); float* ssq = (float*)(ws + WS_SSQ);
    int* tok_e = (int*)(ws + WS_TOKE); float* tok_w = (float*)(ws + WS_TOKW); int* tok_p = (int*)(ws + WS_TOKP);
    int* row_tok = (int*)(ws + WS_ROWTOK); int* row_slot = (int*)(ws + WS_ROWSLOT); float* row_w = (float*)(ws + WS_ROWW); int* chunk_tbl = (int*)(ws + WS_CHUNKE);
    bf16_t* Wt_in = (bf16_t*)(ws + WS_WIN); bf16_t* Wt_uq = (bf16_t*)(ws + WS_WUQ); bf16_t* Wt_ukv = (bf16_t*)(ws + WS_WUKV); bf16_t* Wt_o = (bf16_t*)(ws + WS_WO);
    bf16_t* krope = (bf16_t*)(ws + WS_KROPE); bf16_t* cq = (bf16_t*)(ws + WS_CQ); bf16_t* ckv = (bf16_t*)(ws + WS_CKV); bf16_t* x1b = (bf16_t*)(ws + WS_X1);
    bf16_t* daq = (bf16_t*)(ws + WS_DAQ); bf16_t* dak = (bf16_t*)(ws + WS_DAK); bf16_t* dav = (bf16_t*)(ws + WS_DAV);
    bf16_t* hb = (bf16_t*)((char*)out + 64 * MiB);
    bf16_t* mq = (bf16_t*)(ws + WS_MQ); bf16_t* mkv = (bf16_t*)(ws + WS_MKV);
    bf16_t* W13t = (bf16_t*)(ws + WS_W13); bf16_t* W2t = (bf16_t*)(ws + WS_W2); bf16_t* h2 = (bf16_t*)(ws + WS_H2); bf16_t* he = (bf16_t*)(ws + WS_HE); bf16_t* yb = (bf16_t*)(ws + WS_Y);
    unsigned char* gates = (unsigned char*)out;

    const int lo = args.ph_lo, hi_ph = args.ph_hi;
    { const int tid = otid(); if (tid < 128) ((LAS unsigned*)(lds + MISC_OFF))[tid] = 0u; }
    __syncthreads();
    if (args.coop == 2) cg::this_grid().sync();
    XcdBarrier gbar; gbar.bar = ctl + CW_BAR; gbar.x = 0; gbar.st = nullptr;
    if (args.coop) gbar = xcd_barrier_post(ctl + CW_BAR, (volatile LAS unsigned*)(lds + MISC_OFF) + 8);
#ifndef PHASE_MASK
#define PHASE_MASK 0x3ff
#endif
#define IN(k) (((PHASE_MASK >> (k)) & 1) && lo <= (k) && (k) < hi_ph)
#define REPS(k) for (int rep_ = 0, nr_ = 1 + ((args.rep_mask >> (k)) & 1); rep_ < nr_; ++rep_)
#define DRY (rep_ + 1 < nr_)
#define SEAM(k) do { if (IN(k) && IN((k) + 1)) { xcd_barrier(gbar); } } while (0)

    if (IN(0)) REPS(0) {
        const int tid = otid(), lane = tid & 63; (void)tid;
        LAS float* scr = (LAS float*)(lds + wave * 16384);
        constexpr int I_IN = 16 * 182, I_UQ = 6 * 48, I_UKV = 4 * 64, I_O = 16 * 32, NIT = I_IN + I_UQ + I_UKV + I_O;
        for (int it = gw; it < NIT; it += NGW) {
            int r = it;
            if (r < I_IN) { const int kb = r / 182, nb = r % 182, n0 = nb * 32; transpose_item(w_in, IN_COLS, kb * 64, n0, Wt_in, 1024, n0 < C_PAD ? n0 : n0 + 64, nullptr, scr, lane); continue; } r -= I_IN;
            if (r < I_UQ) { const int kb = r / 48, nb = r % 48; transpose_item(w_uq, MQ_N, kb * 64, nb * 32, Wt_uq, QLORA, nb * 32, q_lora_g, scr, lane); continue; } r -= I_UQ;
            if (r < I_UKV) { const int kb = r / 64, nb = r % 64; transpose_item(w_ukv, MKV_N, kb * 64, nb * 32, Wt_ukv, KVLORA, nb * 32, kv_lora_g, scr, lane); continue; } r -= I_UKV;
            { const int kb = r / 32, nb = r % 32; transpose_item(w_o, DM, kb * 64, nb * 32, Wt_o, DM, nb * 32, nullptr, scr, lane); }
        }
        for (int i = gw * 64 + lane; i < 64 * 1024 / 8; i += NGW * 64) *(u32x4*)(Wt_in + (size_t)C_PAD * 1024 + (size_t)i * 8) = (u32x4){0u, 0u, 0u, 0u};
        const bool rda = lane < 8; const int ri = rda ? lane : lane - 8;
        double rinvf = 1.0; { const double base = rda ? 0.19392274474868576 : 0.6636012376960885; for (int k = 0; k < ri && lane < 40; ++k) rinvf *= base; }
        f32x4 gA[4];
#pragma unroll
        for (int j = 0; j < 4; ++j) gA[j] = ((const f32x4*)attn_norm_g + lane)[64 * j];
        for (int m0 = gw; m0 < MTOK; m0 += 4 * NGW) {
            f32x4 v4[4][4]; int pos4[4];
#pragma unroll
            for (int r = 0; r < 4; ++r) { const int mr = m0 + r * NGW; pos4[r] = (mr < MTOK) ? positions[mr] : 0; if (mr < MTOK) { const f32x4* xr = (const f32x4*)(x + (size_t)mr * DM) + lane;
#pragma unroll
                for (int j = 0; j < 4; ++j) v4[r][j] = xr[64 * j]; } }
#pragma unroll
          for (int r = 0; r < 4; ++r) { const int m = m0 + r * NGW; if (m < MTOK) {
            float s = 0.f;
#pragma unroll
            for (int j = 0; j < 4; ++j) { const f32x4 t = v4[r][j]; s += (t[0] * t[0] + t[1] * t[1]) + (t[2] * t[2] + t[3] * t[3]); }
            const float rinv = __builtin_amdgcn_rsqf(wave_sum(s) * (1.0f / DM) + NORM_EPS);
            u32x2* o8 = (u32x2*)(hb + (size_t)m * DM) + lane;
#pragma unroll
            for (int j = 0; j < 4; ++j) { const f32x4 g = gA[j], t = v4[r][j]; u32x2 w; w.x = cvtpk(t[0] * rinv * g[0], t[1] * rinv * g[1]); w.y = cvtpk(t[2] * rinv * g[2], t[3] * rinv * g[3]); o8[64 * j] = w; }
            if (lane < 40) {
                float sn, cs; sincos_d((double)pos4[r] * rinvf, sn, cs);
                if (rda) { rope_da[(size_t)m * 16 + ri] = cs; rope_da[(size_t)m * 16 + 8 + ri] = sn; } else { rope_ml[(size_t)m * 64 + ri] = cs; rope_ml[(size_t)m * 64 + 32 + ri] = sn; }
            }
          } }
        }
    }
    SEAM(0);

    if (IN(1)) REPS(1) {
        pg8::DenseOrder S; S.init(MTOK, NINP, G, bx);
        epi::EpiInProj E{daq, dak, dav, cq, ckv, krope, gates, ssq, nullptr, da_q_g, da_k_g, k_rope_g, b_gate, rope_da, rope_ml, DRY};
        E.done = ctl + CW_DONE2;
        pg8::gemm_phase<epi::EpiInProj, pg8::DenseOrder, true>(lds, hb, Wt_in, DM, S, E);
    }

    if (IN(2)) REPS(2) {
        const int ext = ((MTOK / 256) * (NINP / 256)) % G;
        { pg8::DenseOrderHand S; S.init(MTOK, MQ_N, G, bx); S.done = ctl + CW_DONE2; S.need = 3u * (MTOK / 256); S.ext = ext;
          epi::EpiMlaQ E{mq, ssq}; pg8::gemm_phase<epi::EpiMlaQ, pg8::DenseOrderHand, true>(lds, cq, Wt_uq, QLORA, S, E); }
        { pg8::DenseOrderHand S; S.init(MTOK, MKV_N, G, bx); S.done = ctl + CW_DONE2; S.need = 3u * (MTOK / 256); S.ext = 0;
          epi::EpiMlaKV E{mkv, ssq, k_nope_g}; pg8::gemm_phase<epi::EpiMlaKV, pg8::DenseOrderHand, true>(lds, ckv, Wt_ukv, KVLORA, S, E); }
    }
    SEAM(2);

    if (IN(3)) REPS(3) {
        float d1 = 0.f, d2 = 0.f;
        for (int i = 0; i < 64; ++i) { d1 += lq1[i] * lk1[i]; d2 += lq2[i] * lk2[i]; }
        att::AttnP P{daq, dak, dav, mq, mkv, krope, gates, daq, subln_g, mla_q_g, rope_ml, __expf(d1) - __expf(d2) + LAMBDA_INIT, DRY, (PROBE_VARIANTS && DRY) ? (args.rep_mask >> 16) : 0};
        att::attn_phase(P, G, vcu, (char*)lds_raw);
    }
    SEAM(3);

    if (IN(4)) REPS(4) {
        const int tid = otid(), lane = tid & 63; (void)tid;
#define TILE_DESC(it_, W_, N_, k0_, n0_, WT_, ldk_, is3_) do { const int e_ = (it_) / 96, r_ = (it_) % 96; \
            if (r_ < 64) { is3_ = r_ >> 5; const int q_ = r_ & 31; k0_ = (q_ >> 1) * 64; n0_ = (q_ & 1) * 256; W_ = (is3_ ? w3 : w1) + (size_t)e_ * DM * DEXP; N_ = DEXP; WT_ = W13t + (size_t)e_ * 1024 * 1024; ldk_ = 1024; } \
            else { const int q_ = r_ - 64; is3_ = -1; k0_ = (q_ >> 2) * 64; n0_ = (q_ & 3) * 256; W_ = w2 + (size_t)e_ * DEXP * DM; N_ = DM; WT_ = W2t + (size_t)e_ * 1024 * 512; ldk_ = 512; } } while (0)
        { f32x4 va[8] = {}, vb[8] = {}; const float *Wa = w1, *Wb = w1; int Na = 0, k0a = 0, n0a = 0, ldka = 0, is3a = 0, Nb = 0, k0b = 0, n0b = 0, ldkb = 0, is3b = 0; bf16_t *WTa = W13t, *WTb = W13t;
          constexpr int NT_ = NEXP * 96;
          int it = bx;
          if (it < NT_) { TILE_DESC(it, Wa, Na, k0a, n0a, WTa, ldka, is3a); ttb_load(va, Wa, Na, k0a, n0a, tid); }
          for (; it < NT_; it += 2 * G) {
              const bool hb_ = it + G < NT_;
              if (hb_) { TILE_DESC(it + G, Wb, Nb, k0b, n0b, WTb, ldkb, is3b); ttb_load(vb, Wb, Nb, k0b, n0b, tid); }
              ttb_finish(va, k0a, n0a, WTa, ldka, is3a, (LAS float*)lds, tid);
              if (!hb_) break;
              if (it + 2 * G < NT_) { TILE_DESC(it + 2 * G, Wa, Na, k0a, n0a, WTa, ldka, is3a); ttb_load(va, Wa, Na, k0a, n0a, tid); }
              ttb_finish(vb, k0b, n0b, WTb, ldkb, is3b, (LAS float*)lds, tid);
          } }
#undef TILE_DESC
        __syncthreads();
        pg8::DenseOrder S; S.init(MTOK, DM, G, bx);
        epi::EpiOut E{x, x1b};
        pg8::gemm_phase<epi::EpiOut, pg8::DenseOrder, true>(lds, daq, Wt_o, DM, S, E);
    }
    SEAM(4);

    if (IN(5)) REPS(5) {
        const bool dry = DRY;
        const int tid = otid(), lane = tid & 63;
        LAS float* Wl = (LAS float*)lds;
        LAS unsigned* misc = (LAS unsigned*)(lds + MISC_OFF);
#define KPOS(k_) ((((k_) >> 9) * 2 + (((k_) >> 2) & 1)) * 256 + (((k_) >> 3) & 63) * 4 + ((k_) & 3))
        for (int i = tid; i < 1024; i += NTHREADS) { const f32x4 w = ((const f32x4*)w_group)[i]; const int kp = KPOS(i);
            Wl[kp] = w[0]; Wl[1024 + kp] = w[1]; Wl[2048 + kp] = w[2]; Wl[3072 + kp] = w[3]; }
        for (int i = tid; i < 8 * 1024; i += NTHREADS) { const f32x4 w = ((const f32x4*)w_router)[i]; const int k = i >> 3, n0 = (i & 7) * 4, kp = KPOS(k);
            Wl[4096 + n0 * 1024 + kp] = w[0]; Wl[4096 + (n0 + 1) * 1024 + kp] = w[1]; Wl[4096 + (n0 + 2) * 1024 + kp] = w[2]; Wl[4096 + (n0 + 3) * 1024 + kp] = w[3]; }
#undef KPOS
        if (tid < 32) { misc[32 + tid] = 0u; ((LAS float*)misc)[96 + tid] = b_router[tid]; }
        const float bg0 = b_group[0], bg1 = b_group[1], bg2 = b_group[2], bg3 = b_group[3];
        for (int r = bx * NTHREADS + tid; r < PROWS; r += G * NTHREADS) { row_tok[r] = 0; row_slot[r] = -1; row_w[r] = 0.f; }
        __syncthreads();
        int rt_ = -1, re0 = 0, re1 = 0, rp0 = 0, rp1 = 0; float rw0 = 0.f, rw1 = 0.f;
        int it = 0;
        u32x4 vn[2], vq[2]; f32x4 gF[4];
#pragma unroll
        for (int j = 0; j < 4; ++j) gF[j] = ((const f32x4*)ffn_norm_g)[128 * (j >> 1) + 2 * lane + (j & 1)];
#pragma unroll
        for (int jj = 0; jj < 2; ++jj) { vn[jj] = (gw < MTOK) ? ((const u32x4*)(x1b + (size_t)gw * DM) + lane)[64 * jj] : (u32x4){0u, 0u, 0u, 0u};
            vq[jj] = (gw + NGW < MTOK) ? ((const u32x4*)(x1b + (size_t)(gw + NGW) * DM) + lane)[64 * jj] : (u32x4){0u, 0u, 0u, 0u}; }
        __builtin_amdgcn_s_waitcnt(0x0F70);
        auto route = [&](f32x4 (&v)[4], const int m) __attribute__((always_inline)) {
            float s = 0.f;
#pragma unroll
            for (int j = 0; j < 4; ++j) s += (v[j][0] * v[j][0] + v[j][1] * v[j][1]) + (v[j][2] * v[j][2] + v[j][3] * v[j][3]);
            const float rinv = __builtin_amdgcn_rsqf(wave_sum(s) * (1.0f / DM) + NORM_EPS);
            u32x4* o8 = (u32x4*)(h2 + (size_t)m * DM) + lane;
#pragma unroll
            for (int j = 0; j < 4; ++j) v[j] = v[j] * rinv * gF[j];
#pragma unroll
            for (int jj = 0; jj < 2; ++jj) { u32x4 w; w.x = cvtpk(v[2 * jj][0], v[2 * jj][1]); w.y = cvtpk(v[2 * jj][2], v[2 * jj][3]); w.z = cvtpk(v[2 * jj + 1][0], v[2 * jj + 1][1]); w.w = cvtpk(v[2 * jj + 1][2], v[2 * jj + 1][3]); o8[64 * jj] = w; }
            const bool lb0 = lane & 1, lb1 = (lane >> 1) & 1;
            float gl[4];
            { float pa[4];
#pragma unroll
              for (int n = 0; n < 4; ++n) { f32x2 a2 = {0.f, 0.f};
#pragma unroll
                  for (int j = 0; j < 4; ++j) { const f32x4 w = *(const LAS f32x4*)(Wl + n * 1024 + 256 * j + 4 * lane);
                      a2 = (f32x2){v[j][0], v[j][1]} * (f32x2){w[0], w[1]} + a2; a2 = (f32x2){v[j][2], v[j][3]} * (f32x2){w[2], w[3]} + a2; }
                  pa[n] = a2[0] + a2[1]; }
              const float t = red4(pa, lb0, lb1);
              gl[0] = RDLANE(t, 0) + bg0; gl[1] = RDLANE(t, 1) + bg1; gl[2] = RDLANE(t, 2) + bg2; gl[3] = RDLANE(t, 3) + bg3; }
            int gs = 0; float gm = gl[0];
#pragma unroll
            for (int n = 1; n < 4; ++n) if (gl[n] > gm) { gm = gl[n]; gs = n; }
            float gden = 0.f;
#pragma unroll
            for (int n = 0; n < 4; ++n) gden += __expf(gl[n] - gm);
            const float pg = 1.0f / gden;
            gs = __builtin_amdgcn_readfirstlane(gs);
            float el[8];
            { float pa[8];
#pragma unroll
              for (int n = 0; n < 8; ++n) { f32x2 a2 = {0.f, 0.f}; const LAS float* wp = Wl + 4096 + (gs * 8 + n) * 1024 + 4 * lane;
#pragma unroll
                  for (int j = 0; j < 4; ++j) { const f32x4 w = *(const LAS f32x4*)(wp + 256 * j);
                      a2 = (f32x2){v[j][0], v[j][1]} * (f32x2){w[0], w[1]} + a2; a2 = (f32x2){v[j][2], v[j][3]} * (f32x2){w[2], w[3]} + a2; }
                  pa[n] = a2[0] + a2[1]; }
              float t0, t1; red8(pa, lb0, lb1, t0, t1);
              const LAS float* bb = (const LAS float*)misc + 96 + gs * 8;
#pragma unroll
              for (int n = 0; n < 4; ++n) { el[n] = RDLANE(t0, n) + bb[n]; el[4 + n] = RDLANE(t1, n) + bb[4 + n]; } }
            int i0 = 0; float v0 = el[0];
#pragma unroll
            for (int n = 1; n < 8; ++n) if (el[n] > v0) { v0 = el[n]; i0 = n; }
            int i1 = -1; float v1 = 0.f;
#pragma unroll
            for (int n = 0; n < 8; ++n) if (n != i0 && (i1 < 0 || el[n] > v1)) { v1 = el[n]; i1 = n; }
            const float ex = __expf(v1 - v0); const float wa = pg / (1.0f + ex), wb = pg * ex / (1.0f + ex);
            const int e0 = gs * 8 + i0, e1 = gs * 8 + i1;
            int p0 = 0, p1 = 0;
            if (lane == 0) { p0 = (int)__hip_atomic_fetch_add(misc + 32 + e0, 1u, __ATOMIC_RELAXED, __HIP_MEMORY_SCOPE_WORKGROUP); p1 = (int)__hip_atomic_fetch_add(misc + 32 + e1, 1u, __ATOMIC_RELAXED, __HIP_MEMORY_SCOPE_WORKGROUP); }
            p0 = __shfl(p0, 0); p1 = __shfl(p1, 0);
            if (lane == it) { rt_ = m; re0 = e0; re1 = e1; rp0 = p0; rp1 = p1; rw0 = wa; rw1 = wb; }
        };
#define ROW_CVT(v_, b_) do { _Pragma("unroll") for (int jj = 0; jj < 2; ++jj) { v_[2 * jj] = (f32x4){bf_lo(b_[jj].x), bf_hi(b_[jj].x), bf_lo(b_[jj].y), bf_hi(b_[jj].y)}; v_[2 * jj + 1] = (f32x4){bf_lo(b_[jj].z), bf_hi(b_[jj].z), bf_lo(b_[jj].w), bf_hi(b_[jj].w)}; } } while (0)
#define ROW_LD(b_, m_) do { const int mm_ = (m_) < MTOK ? (m_) : gw; const u32x4* xn_ = (const u32x4*)(x1b + (size_t)mm_ * DM) + lane; b_[0] = xn_[0]; b_[1] = xn_[64]; } while (0)
        for (int m = gw; m < MTOK; m += 2 * NGW) {
            f32x4 v[4];
            ROW_CVT(v, vn); ROW_LD(vn, m + 2 * NGW);
            route(v, m); ++it;
            if (m + NGW >= MTOK) break;
            ROW_CVT(v, vq); ROW_LD(vq, m + 3 * NGW);
            route(v, m + NGW); ++it;
        }
#undef ROW_CVT
#undef ROW_LD
        __syncthreads();
        if (tid < 32) misc[64 + tid] = __hip_atomic_fetch_add(ctl + CW_GCNT + tid, dry ? 0u : misc[32 + tid], __ATOMIC_RELAXED, __HIP_MEMORY_SCOPE_AGENT);
        __syncthreads();
        if (rt_ >= 0 && !dry) { tok_e[2 * rt_] = re0; tok_e[2 * rt_ + 1] = re1; tok_w[2 * rt_] = rw0; tok_w[2 * rt_ + 1] = rw1;
            tok_p[2 * rt_] = (int)misc[64 + re0] + rp0; tok_p[2 * rt_ + 1] = (int)misc[64 + re1] + rp1; }
    }
    SEAM(5);

    if (IN(6)) REPS(6) {
        const int tid = otid();
        LAS int* cs = (LAS int*)(lds + MISC_OFF) + 90;
        if (tid == 0) { int acc_ = 0; for (int e = 0; e < NEXP; ++e) { cs[e] = acc_; acc_ += ((int)__hip_atomic_load(ctl + CW_GCNT + e, __ATOMIC_RELAXED, __HIP_MEMORY_SCOPE_AGENT) + 255) >> 8; } cs[NEXP] = acc_; }
        __syncthreads();
        if (bx == 0) { if (tid == 0) chunk_tbl[0] = cs[NEXP]; for (int e = tid; e < NEXP; e += NTHREADS) for (int c = cs[e]; c < cs[e + 1]; ++c) chunk_tbl[16 + c] = e; }
        for (int t = bx * NTHREADS + tid; t < MTOK; t += G * NTHREADS) {
#pragma unroll
            for (int k = 0; k < 2; ++k) { const int e = tok_e[2 * t + k]; const int r = 256 * cs[e] + tok_p[2 * t + k]; row_tok[r] = t; row_slot[r] = 2 * t + k; row_w[r] = tok_w[2 * t + k]; }
        }
    }
    SEAM(6);

    if (IN(7)) REPS(7) {
        pg8::GroupOrder<true> S{4 * chunk_tbl[0], G, vcu, chunk_tbl + 16, row_tok};
        epi::EpiSwiglu E{he, ctl + CW_DONE};
        pg8::gemm_phase<epi::EpiSwiglu, pg8::GroupOrder<true>, true>(lds, h2, W13t, DM, S, E);
    }

    if (IN(8)) REPS(8) {
        pg8::GroupOrderBal S{4 * chunk_tbl[0], G, vcu, chunk_tbl + 16, row_tok, ctl + CW_DONE};
        epi::EpiDown E{yb, row_slot, row_w};
        pg8::gemm_phase<epi::EpiDown, pg8::GroupOrderBal, true>(lds, he, W2t, DEXP, S, E);
    }
    SEAM(8);

    if (IN(9)) REPS(9) {
        const bool dry = DRY;
        const int lane = otid() & 63;
        for (int m0 = gw; m0 < MTOK; m0 += 4 * NGW) {
            u32x2 v[4][4], ya[4][4], yc[4][4];
#pragma unroll
            for (int r = 0; r < 4; ++r) { const int m = m0 + r * NGW; if (m < MTOK) {
                const u32x2* xr = (const u32x2*)(x1b + (size_t)m * DM) + lane; const u32x2* y0 = (const u32x2*)(yb + (size_t)(2 * m) * DM) + lane; const u32x2* y1 = (const u32x2*)(yb + (size_t)(2 * m + 1) * DM) + lane;
#pragma unroll
                for (int j = 0; j < 4; ++j) { v[r][j] = xr[64 * j]; ya[r][j] = y0[64 * j]; yc[r][j] = y1[64 * j]; } } }
#pragma unroll
            for (int r = 0; r < 4; ++r) { const int m = m0 + r * NGW; if (m < MTOK) { f32x4* xr = (f32x4*)(out + (size_t)m * DM) + lane;
#pragma unroll
                for (int j = 0; j < 4; ++j) { const u32x2 c = v[r][j], a = ya[r][j], b = yc[r][j]; f32x4 w;
                    w[0] = bf_lo(c.x) + (bf_lo(a.x) + bf_lo(b.x)); w[1] = bf_hi(c.x) + (bf_hi(a.x) + bf_hi(b.x)); w[2] = bf_lo(c.y) + (bf_lo(a.y) + bf_lo(b.y)); w[3] = bf_hi(c.y) + (bf_hi(a.y) + bf_hi(b.y)); asm volatile("" : "+v"(w)); if (!dry) xr[64 * j] = w; } } }
        }
    }
#undef IN
#undef SEAM
#undef REPS
#undef DRY
}

extern "C" void kernel_launch(void* const* d_in, const int* in_sizes, int n_in, void* d_out, int out_size, void* d_ws, size_t ws_size, hipStream_t stream) {
    static int grid = 0;
    if (grid == 0) {
        if (n_in != 28 || out_size != MTOK * DM || ws_size < WS_END) { fprintf(stderr, "kernel_launch: unexpected shapes (n_in %d out %d ws %zu)\n", n_in, out_size, ws_size); grid = -1; return; }
        int dev = 0, cus = 0, per_cu = 0;
        hipGetDevice(&dev); hipDeviceGetAttribute(&cus, hipDeviceAttributeMultiprocessorCount, dev);
        hipFuncSetAttribute((const void*)hybrid_fwd, hipFuncAttributeMaxDynamicSharedMemorySize, LDS_BYTES);
        hipOccupancyMaxActiveBlocksPerMultiprocessor(&per_cu, (const void*)hybrid_fwd, NTHREADS, LDS_BYTES);
        (void)hipGetLastError();
        if (per_cu < 1) { fprintf(stderr, "kernel_launch: occupancy query says %d blocks/CU\n", per_cu); per_cu = 1; }
        grid = cus * 1;
    }
    if (grid < 0) return;
    hipMemsetAsync((char*)d_ws + WS_CTL, 0, CTL_ZERO_BYTES, stream);
    Args a{};
    for (int i = 0; i < 28; ++i) a.in[i] = d_in[i];
    a.out = (float*)d_out; a.ws = (unsigned char*)d_ws; a.rep_mask = PROBE_REP_MASK;
#if N_LAUNCH_SPLIT
    for (int p = 0; p < NPHASE; ++p) { a.ph_lo = p; a.ph_hi = p + 1; a.coop = 0; hipLaunchKernelGGL(hybrid_fwd, dim3(grid), dim3(NTHREADS), LDS_BYTES, stream, a); }
#else
    a.ph_lo = 0; a.ph_hi = NPHASE; a.coop = 1;
    void* kargs[] = {&a};
    hipError_t e = hipLaunchCooperativeKernel((const void*)hybrid_fwd, dim3(grid), dim3(NTHREADS), kargs, LDS_BYTES, stream);
    if (e != hipSuccess) fprintf(stderr, "cooperative launch failed: %s (grid %d)\n", hipGetErrorString(e), grid);
#endif
}
```

```cpp
#include <hip/hip_runtime.h>
#include <hip/hip_cooperative_groups.h>
#include <cstdio>
#include <cstdint>
namespace cg = cooperative_groups;

#ifndef PROBE_REP_MASK
#define PROBE_REP_MASK 0
#endif
#ifndef PROBE_VARIANTS
#define PROBE_VARIANTS 0
#endif
#ifndef N_LAUNCH_SPLIT
#define N_LAUNCH_SPLIT 0
#endif

#define LAS __attribute__((address_space(3)))
#define GAS __attribute__((address_space(1)))
typedef unsigned short bf16_t;
typedef short bf16x8 __attribute__((ext_vector_type(8)));
typedef short s16x4 __attribute__((ext_vector_type(4)));
typedef float f32x2 __attribute__((ext_vector_type(2)));
typedef float f32x4 __attribute__((ext_vector_type(4)));
typedef float f32x16 __attribute__((ext_vector_type(16)));
typedef unsigned u32x2 __attribute__((ext_vector_type(2)));
typedef unsigned u32x4 __attribute__((ext_vector_type(4)));
typedef __bf16 bf16x2_t __attribute__((ext_vector_type(2)));
typedef GAS unsigned gu32;

constexpr int BATCH = 8, SEQ = 4096, DM = 1024, MTOK = BATCH * SEQ;
constexpr int NHEAD = 8;
constexpr int IN_COLS = 5824, NINP = 5888;
constexpr int C_K = 1024, C_V = 2048, C_CQ = 3072, C_CKV = 3456, C_KR = 3712, C_PAD = 3776, C_G = 3840;
constexpr int QLORA = 384, KVLORA = 256, MQ_N = 1536, MKV_N = 2048;
constexpr int NEXP = 32, DEXP = 512, TOPK = 2;
constexpr int MAXCHUNK = 288, PROWS = MAXCHUNK * 256;
constexpr float NORM_EPS = 1e-6f;
constexpr float LOG2E = 1.4426950408889634f;
constexpr float C2_DA = 0.125f * LOG2E;
constexpr float C2_MLA = 0.07216878364870322f * LOG2E;
constexpr float LAMBDA_INIT = 0.8f - 0.6f;
constexpr double ROPE_THETA = 500000.0;

constexpr size_t MiB = 1u << 20;
constexpr size_t WS_CTL = 0, CTL_ZERO_BYTES = 64 * 1024;
constexpr size_t WS_ROPE_DA = 1 * MiB;
constexpr size_t WS_ROPE_ML = 3 * MiB;
constexpr size_t WS_SSQ = 11 * MiB;
constexpr size_t WS_TOKE = 13 * MiB;
constexpr size_t WS_TOKW = WS_TOKE + 256 * 1024;
constexpr size_t WS_TOKP = WS_TOKW + 256 * 1024;
constexpr size_t WS_ROWTOK = 14 * MiB;
constexpr size_t WS_ROWSLOT = WS_ROWTOK + 512 * 1024;
constexpr size_t WS_ROWW = WS_ROWSLOT + 512 * 1024;
constexpr size_t WS_CHUNKE = WS_ROWW + 512 * 1024;
constexpr size_t WS_WIN = 16 * MiB;
constexpr size_t WS_WUQ = 28 * MiB;
constexpr size_t WS_WUKV = 30 * MiB;
constexpr size_t WS_WO = 504 * MiB;
constexpr size_t WS_X1 = 16 * MiB;
constexpr size_t WS_KROPE = 34 * MiB;
constexpr size_t WS_CQ = 38 * MiB;
constexpr size_t WS_CKV = 62 * MiB;
constexpr size_t WS_DAQ = 80 * MiB;
constexpr size_t WS_DAK = 144 * MiB;
constexpr size_t WS_DAV = 208 * MiB;
constexpr size_t WS_H = 272 * MiB;
constexpr size_t WS_MQ = 272 * MiB;
constexpr size_t WS_MKV = 368 * MiB;
constexpr size_t WS_W13 = 144 * MiB;
constexpr size_t WS_W2 = 208 * MiB;
constexpr size_t WS_H2 = 240 * MiB;
constexpr size_t WS_HE = 304 * MiB;
constexpr size_t WS_Y = 376 * MiB;
constexpr size_t WS_END = 506 * MiB;
constexpr int CW_GCNT = 64;
constexpr int CW_BAR = 4096;
constexpr int CW_DONE = 8192, DONE_STRIDE = 16;

constexpr int RING_BYTES = 131072;
constexpr int EXCH_OFF = 131072;
constexpr int STAGE_ROW = 132;
constexpr int OSTG_BYTES = 32 * STAGE_ROW * 4;
constexpr int MISC_OFF = 147456;
constexpr int WSF_OFF = 147968;
constexpr int LDS_BYTES = 150528;

__device__ __forceinline__ unsigned cvtpk(float lo, float hi) { f32x2 v = {lo, hi}; bf16x2_t b = __builtin_convertvector(v, bf16x2_t); return __builtin_bit_cast(unsigned, b); }
__device__ __forceinline__ float bf_lo(unsigned w) { return __uint_as_float(w << 16); }
#define UB(w_, k_) ((float)(((w_) >> (8 * (k_))) & 0xffu))
__device__ __forceinline__ float bf_hi(unsigned w) { return __uint_as_float(w & 0xffff0000u); }
__device__ __forceinline__ float dpp_add(float v, const int ctrl_sel) {
    const int x = __builtin_bit_cast(int, v); int y;
    if (ctrl_sel == 0) y = __builtin_amdgcn_update_dpp(x, x, 0xB1, 0xF, 0xF, false);
    else if (ctrl_sel == 1) y = __builtin_amdgcn_update_dpp(x, x, 0x4E, 0xF, 0xF, false);
    else if (ctrl_sel == 2) y = __builtin_amdgcn_update_dpp(x, x, 0x141, 0xF, 0xF, false);
    else y = __builtin_amdgcn_update_dpp(x, x, 0x140, 0xF, 0xF, false);
    return v + __builtin_bit_cast(float, y);
}
__device__ __forceinline__ float wave_sum(float v) {
    v = dpp_add(v, 0); v = dpp_add(v, 1); v = dpp_add(v, 2); v = dpp_add(v, 3);
    const int x = __builtin_bit_cast(int, v);
    const float r0 = __builtin_bit_cast(float, __builtin_amdgcn_readlane(x, 0)), r1 = __builtin_bit_cast(float, __builtin_amdgcn_readlane(x, 16));
    const float r2 = __builtin_bit_cast(float, __builtin_amdgcn_readlane(x, 32)), r3 = __builtin_bit_cast(float, __builtin_amdgcn_readlane(x, 48));
    return (r0 + r1) + (r2 + r3);
}
__device__ __forceinline__ float sigmoidf_fast(float x) { return __builtin_amdgcn_rcpf(1.0f + __builtin_amdgcn_exp2f(-x * LOG2E)); }
__device__ __forceinline__ int otid() { int t = threadIdx.x; asm volatile("" : "+v"(t)); return t; }
#define LDS_WAIT() asm volatile("s_waitcnt lgkmcnt(0)" ::: "memory")
#define VM_WAIT() asm volatile("s_waitcnt vmcnt(0)" ::: "memory")

namespace pg8 {
constexpr int BM = 256, BK = 64, HALF = 128, HTB = HALF * BK * 2, STAGE_BYTES = 8 * HTB;
__host__ __device__ __forceinline__ int lds_byte(int r, int c) { const int st = (r >> 4) * 2 + (c >> 5), rr = r & 15, cc = c & 31, ob = rr * 64 + cc * 2; return st * 1024 + (ob ^ (((ob >> 9) & 1) << 5)); }
__host__ __device__ __forceinline__ void stage_rc(int b, int& R, int& C) { const int st = b / 1024, sb = b % 1024, swz = sb ^ (((sb >> 9) & 1) << 5); R = (st >> 1) * 16 + swz / 64; C = (st & 1) * 32 + (swz % 64) / 2; }
__host__ __device__ __forceinline__ int perm32(int rho) { const int n = rho >> 4, i = rho & 15; return 8 * (i >> 2) + 4 * n + (i & 3); }

struct Unit { int pm, pn, brow; };

template <class Epi, class Sched, bool ALIGN_EPI>
__device__ __forceinline__ void gemm_phase(LAS unsigned char* lds, const bf16_t* A, const bf16_t* Bt, const int K_, const Sched& S, const Epi& E) {
    constexpr int MODE = Epi::MODE; constexpr bool GATHER = Sched::GATHER;
    int K = K_; asm volatile("" : "+s"(K));
    int tid_ = threadIdx.x; asm volatile("" : "+v"(tid_));
    const int tid = tid_, wid = __builtin_amdgcn_readfirstlane(tid >> 6), lane = tid & 63, wr = wid >> 2, wc = wid & 3, fr = lane & 15, fq = lane >> 4;
    const int nt = K / BK;
    unsigned voffB[2]; unsigned vA[2]; int Rr[2], Cc[2];
#pragma unroll
    for (int i = 0; i < 2; ++i) { int R, C; stage_rc(tid * 16 + i * 8192, R, C); Rr[i] = R; Cc[i] = C;
        const int Rb = MODE == 2 ? (2 * (R & ~31) + perm32(R & 31)) : MODE == 1 ? ((R & ~31) + perm32(R & 31)) : R;
        vA[i] = (unsigned)(R * K + C) * 2u; voffB[i] = (unsigned)(Rb * K + C) * 2u; }
    const size_t kstep = (size_t)(BK * 2);
    const size_t hstepA = (size_t)HALF * K * 2;
    const size_t hstepB = MODE == 2 ? (size_t)32 * K * 2 : (size_t)HALF * K * 2;
    const size_t tstep = 2 * hstepA;
    const unsigned ldsw = (unsigned)wid * 1024u;
    const int aoff = lds_byte(wr * 64 + fr, fq * 8), boff = lds_byte(wc * 32 + fr, fq * 8);
#define PG8_SA(b, h) (((b) * 2 + (h)) * HTB)
#define PG8_SB(b, h) ((4 + (b) * 2 + (h)) * HTB)
#define PG8_STAGE(bufoff, gbase, voff) do { _Pragma("unroll") for (int _i = 0; _i < 2; ++_i) \
        __builtin_amdgcn_global_load_lds((const unsigned*)((const char*)(gbase) + (voff)[_i]), (LAS unsigned*)(lds + (bufoff) + ldsw + _i * 8192), 16, 0, 0); } while (0)
#define PG8_LDA(dst, b, h) do { _Pragma("unroll") for (int m = 0; m < 4; ++m) _Pragma("unroll") for (int k = 0; k < 2; ++k) dst[m][k] = *(const LAS bf16x8*)(lds + PG8_SA(b, h) + aoff + m * 2048 + k * 1024); } while (0)
#define PG8_LDB(dst, b, h) do { _Pragma("unroll") for (int n = 0; n < 2; ++n) _Pragma("unroll") for (int k = 0; k < 2; ++k) dst[n][k] = *(const LAS bf16x8*)(lds + PG8_SB(b, h) + boff + n * 2048 + k * 1024); } while (0)
#define PG8_MMA(ai, bj, At, Bt_) do { __builtin_amdgcn_s_setprio(1); _Pragma("unroll") for (int m = 0; m < 4; ++m) _Pragma("unroll") for (int n = 0; n < 2; ++n) _Pragma("unroll") for (int k = 0; k < 2; ++k) \
        acc[ai][bj][m][n] = __builtin_amdgcn_mfma_f32_16x16x32_bf16(Bt_[n][k], At[m][k], acc[ai][bj][m][n], 0, 0, 0); __builtin_amdgcn_s_setprio(0); } while (0)
#define PG8_WAIT_V(n) asm volatile("s_waitcnt vmcnt(" #n ")" ::: "memory")
#define PG8_WAIT_L(n) asm volatile("s_waitcnt lgkmcnt(" #n ")" ::: "memory")
#define PG8_BAR __builtin_amdgcn_s_barrier()
#define PG8_SCHED __builtin_amdgcn_sched_barrier(0)
    Unit cur, nxt; int ui = 0;
    if (!S.next(0, cur)) return;
    if constexpr (Sched::WAITS) { if (wid == 0) S.wait(cur, lane); __builtin_amdgcn_s_barrier(); }
    int sig = -1;
    f32x4 acc[2][2][4][2];
#pragma unroll
    for (int a = 0; a < 2; ++a)
#pragma unroll
        for (int b = 0; b < 2; ++b)
#pragma unroll
            for (int m = 0; m < 4; ++m)
#pragma unroll
                for (int n = 0; n < 2; ++n) acc[a][b][m][n] = (f32x4){0.f, 0.f, 0.f, 0.f};
    bf16x8 At[4][2], B0[2][2], B1[2][2];
    unsigned cA0[2], cA1[2], nA0[2], nA1[2];
    const char* cA; const char* cB;
    if constexpr (GATHER) {
        cA = (const char*)A;
#pragma unroll
        for (int i = 0; i < 2; ++i) { cA0[i] = (unsigned)(S.row_tok[cur.pm * 256 + Rr[i]] * K + Cc[i]) * 2u; cA1[i] = (unsigned)(S.row_tok[cur.pm * 256 + 128 + Rr[i]] * K + Cc[i]) * 2u; }
    } else {
        cA = (const char*)A + (size_t)cur.pm * tstep;
#pragma unroll
        for (int i = 0; i < 2; ++i) { cA0[i] = vA[i]; cA1[i] = vA[i] + (unsigned)hstepA; }
    }
    cB = (const char*)Bt + (size_t)cur.brow * K * 2;
    PG8_STAGE(PG8_SB(0, 0), cB, voffB); PG8_STAGE(PG8_SB(0, 1), cB + hstepB, voffB); PG8_STAGE(PG8_SA(0, 0), cA, cA0); PG8_STAGE(PG8_SA(0, 1), cA, cA1);
    if (wr == 1) PG8_BAR;
    PG8_WAIT_V(2); PG8_BAR;
    PG8_STAGE(PG8_SB(1, 0), cB + kstep, voffB); PG8_STAGE(PG8_SA(1, 0), cA + kstep, cA0); PG8_STAGE(PG8_SB(1, 1), cB + hstepB + kstep, voffB);
    PG8_WAIT_V(6); PG8_BAR;
    for (;;) {
        const bool has_next = S.next(ui + 1, nxt);
        const char* nA; const char* nB;
        if (has_next) {
            nB = (const char*)Bt + (size_t)nxt.brow * K * 2;
            if constexpr (GATHER) {
                nA = (const char*)A;
#pragma unroll
                for (int i = 0; i < 2; ++i) { nA0[i] = (unsigned)(S.row_tok[nxt.pm * 256 + Rr[i]] * K + Cc[i]) * 2u; nA1[i] = (unsigned)(S.row_tok[nxt.pm * 256 + 128 + Rr[i]] * K + Cc[i]) * 2u; }
            } else {
                nA = (const char*)A + (size_t)nxt.pm * tstep;
#pragma unroll
                for (int i = 0; i < 2; ++i) { nA0[i] = cA0[i]; nA1[i] = cA1[i]; }
            }
        } else { nA = cA; nB = cB;
#pragma unroll
            for (int i = 0; i < 2; ++i) { nA0[i] = cA0[i]; nA1[i] = cA1[i]; } }
        if constexpr (Sched::WAITS) { if (has_next && wid == 0) S.wait(nxt, lane); }
        for (int t = 0; t < nt; t += 2) {
            const bool last = (t == nt - 2);
            const char* a1 = cA + (size_t)(t + 1) * kstep;
            const char* a2 = last ? nA : cA + (size_t)(t + 2) * kstep; const char* b2 = last ? nB : cB + (size_t)(t + 2) * kstep;
            const char* a3 = a2 + kstep; const char* b3 = b2 + kstep;
            unsigned o20[2], o21[2];
#pragma unroll
            for (int i = 0; i < 2; ++i) { o20[i] = last ? nA0[i] : cA0[i]; o21[i] = last ? nA1[i] : cA1[i]; }
            PG8_LDB(B0, 0, 0); PG8_LDB(B1, 0, 1); PG8_SCHED; PG8_LDA(At, 0, 0); PG8_STAGE(PG8_SA(1, 1), a1, cA1);
            PG8_WAIT_V(8); PG8_WAIT_L(0); PG8_BAR; PG8_MMA(0, 0, At, B0); PG8_MMA(0, 1, At, B1); PG8_BAR; PG8_SCHED;
            PG8_LDA(At, 0, 1); PG8_STAGE(PG8_SB(0, 0), b2, voffB); PG8_STAGE(PG8_SB(0, 1), b2 + hstepB, voffB); PG8_STAGE(PG8_SA(0, 0), a2, o20);
            PG8_WAIT_V(8); PG8_WAIT_L(0); PG8_BAR; PG8_MMA(1, 0, At, B0); PG8_MMA(1, 1, At, B1); PG8_BAR; PG8_SCHED;
            PG8_LDB(B0, 1, 0); PG8_LDB(B1, 1, 1); PG8_SCHED; PG8_LDA(At, 1, 0); PG8_STAGE(PG8_SA(0, 1), a2, o21);
            PG8_WAIT_V(8); PG8_WAIT_L(0); PG8_BAR; PG8_MMA(0, 0, At, B0); PG8_MMA(0, 1, At, B1); PG8_BAR; PG8_SCHED;
            PG8_LDA(At, 1, 1); PG8_STAGE(PG8_SB(1, 0), b3, voffB); PG8_STAGE(PG8_SB(1, 1), b3 + hstepB, voffB); PG8_STAGE(PG8_SA(1, 0), a3, o20);
            PG8_WAIT_V(8); PG8_WAIT_L(0); PG8_BAR; PG8_MMA(1, 0, At, B0); PG8_MMA(1, 1, At, B1); PG8_BAR; PG8_SCHED;
        }
        if constexpr (Epi::SIGNAL) { if (sig >= 0 && tid == 0) __hip_atomic_fetch_add(E.done + DONE_STRIDE * sig, 1u, __ATOMIC_RELAXED, __HIP_MEMORY_SCOPE_AGENT); }
        if constexpr (ALIGN_EPI) { if (wr == 0) PG8_BAR; }
        E(acc, cur, wr, wc, fr, fq, lds);
        if constexpr (Epi::SIGNAL) sig = cur.pm;
        if (!has_next) break;
#pragma unroll
        for (int a = 0; a < 2; ++a)
#pragma unroll
            for (int b = 0; b < 2; ++b)
#pragma unroll
                for (int m = 0; m < 4; ++m)
#pragma unroll
                    for (int n = 0; n < 2; ++n) acc[a][b][m][n] = (f32x4){0.f, 0.f, 0.f, 0.f};
        cur = nxt; cA = nA; cB = nB; ++ui;
#pragma unroll
        for (int i = 0; i < 2; ++i) { cA0[i] = nA0[i]; cA1[i] = nA1[i]; }
        if constexpr (ALIGN_EPI) { if (wr == 1) PG8_BAR; }
    }
    PG8_WAIT_V(0);
    if constexpr (!ALIGN_EPI) { if (wr == 0) PG8_BAR; }
    PG8_BAR;
    if constexpr (Epi::SIGNAL) { if (sig >= 0 && tid == 0) __hip_atomic_fetch_add(E.done + DONE_STRIDE * sig, 1u, __ATOMIC_RELAXED, __HIP_MEMORY_SCOPE_AGENT); }
#undef PG8_SA
#undef PG8_SB
#undef PG8_STAGE
#undef PG8_LDA
#undef PG8_LDB
#undef PG8_MMA
#undef PG8_WAIT_V
#undef PG8_WAIT_L
#undef PG8_BAR
#undef PG8_SCHED
}

struct DenseOrder {
    static constexpr bool GATHER = false, WAITS = false;
    int nM, nN, nwg, G, c; const int* row_tok;
    __device__ void init(int M, int N, int G_, int c_) { nM = M / BM; nN = N / BM; nwg = nM * nN; G = G_; c = c_; row_tok = nullptr; }
    __device__ bool next(int i, Unit& u) const {
        const long L = (long)i * G + c; if (L >= nwg) return false;
        int wgid = (int)L; { const int q = nwg / 8, r = nwg % 8, xcd = wgid % 8, off = wgid / 8; wgid = (xcd < r ? xcd * (q + 1) : r * (q + 1) + (xcd - r) * q) + off; }
        const int nig = 8 * nN, gid = wgid / nig, fm = gid * 8, gsz = (nM - fm) < 8 ? (nM - fm) : 8;
        u.pm = fm + ((wgid % nig) % gsz); u.pn = (wgid % nig) / gsz; u.brow = u.pn * 256; return true;
    }
};
template <bool GATHER_> struct GroupOrder {
    static constexpr bool GATHER = GATHER_, WAITS = false;
    int nunits, G, vcu; const int* chunk_e; const int* row_tok;
    __device__ bool next(int i, Unit& u) const {
        const int L = i * G + vcu; if (L >= nunits) return false;
        const int ch = L >> 2; u.pm = ch; u.pn = L & 3; u.brow = chunk_e[ch] * 1024 + (L & 3) * 256; return true;
    }
};
struct GroupOrderBal {
    static constexpr bool GATHER = false, WAITS = true;
    int nunits, G, vcu; const int* chunk_e; const int* row_tok; const unsigned* done;
    __device__ bool next(int i, Unit& u) const {
        const int full = nunits / G, r1 = nunits - full * G;
        int L;
        if (r1 == 0 || full < 2) { L = i * G + vcu; if (L >= nunits) return false; }
        else if (vcu < r1) { if (i >= full - 1) return false; L = i * G + vcu; }
        else if (i < full) L = i * G + vcu;
        else { const int k = (i - full) * (G - r1) + (vcu - r1); if (k >= 2 * r1) return false; L = (k < r1) ? (full - 1) * G + k : full * G + (k - r1); }
        const int ch = L >> 2; u.pm = ch; u.pn = L & 3; u.brow = chunk_e[ch] * 1024 + (L & 3) * 256; return true;
    }
    __device__ __forceinline__ void wait(const Unit& u, int lane) const {
        if (lane == 0) { const unsigned* p = done + DONE_STRIDE * u.pm; unsigned spins = 0;
            while (__hip_atomic_load(p, __ATOMIC_RELAXED, __HIP_MEMORY_SCOPE_AGENT) < 4u && ++spins < (1u << 22)) __builtin_amdgcn_s_sleep(4); }
        __builtin_amdgcn_fence(__ATOMIC_ACQUIRE, "agent");
        asm volatile("s_waitcnt vmcnt(0)" ::: "memory");
    }
};
}

namespace epi {
using pg8::Unit;
typedef f32x4 Acc[2][2][4][2];

struct EpiInProj {
    static constexpr int MODE = 2; static constexpr bool SIGNAL = false;
    bf16_t *daq, *dak, *dav, *cq, *ckv, *krope; unsigned char* gates; float* ssq;
    const float *gq, *gk, *gkr, *bgate, *rope_da, *rope_ml; bool dry;
    __device__ __forceinline__ void operator()(const Acc& acc, const Unit& u, int wr, int wc, int fr, int fq, LAS unsigned char*) const {
        if (dry) { asm volatile("" :: "v"(acc[0][0][0][0]), "v"(acc[1][1][3][1])); return; }
        const int c0 = u.pn * 256 + wc * 64;
        const int rbase = u.pm * 256 + wr * 64 + fr;
        if (c0 < C_V) {
            const bool isq = c0 < C_K; const float* g = isq ? gq : gk; bf16_t* outp = (isq ? daq : dak) + (c0 & 1023);
            const float osc = isq ? C2_DA : 1.0f;
            f32x4 gv[2][2];
#pragma unroll
            for (int bj = 0; bj < 2; ++bj)
#pragma unroll
                for (int n = 0; n < 2; ++n) gv[bj][n] = *(const f32x4*)(g + 32 * bj + 8 * fq + 4 * n) * osc;
            f32x4 tcs[2], tsn[2], ncs[2], nsn[2];
            { const float* rt0 = rope_da + (size_t)rbase * 16;
#pragma unroll
              for (int n = 0; n < 2; ++n) { tcs[n] = *(const f32x4*)(rt0 + 4 * n); tsn[n] = *(const f32x4*)(rt0 + 8 + 4 * n); } }
#pragma unroll
            for (int ai = 0; ai < 2; ++ai)
#pragma unroll
                for (int m = 0; m < 4; ++m) {
                    const int row = rbase + ai * 128 + m * 16;
                    { const int g1 = ai * 4 + m + 1; if (g1 < 8) { const float* rt1 = rope_da + (size_t)(rbase + (g1 >> 2) * 128 + (g1 & 3) * 16) * 16;
#pragma unroll
                        for (int n = 0; n < 2; ++n) { ncs[n] = *(const f32x4*)(rt1 + 4 * n); nsn[n] = *(const f32x4*)(rt1 + 8 + 4 * n); } } }
                    float ss = 0.f;
#pragma unroll
                    for (int bj = 0; bj < 2; ++bj)
#pragma unroll
                        for (int n = 0; n < 2; ++n) { const f32x4 v = acc[ai][bj][m][n]; ss += (v[0] * v[0] + v[1] * v[1]) + (v[2] * v[2] + v[3] * v[3]); }
                    ss += __shfl_xor(ss, 16); ss += __shfl_xor(ss, 32);
                    const float rinv = __builtin_amdgcn_rsqf(ss * (1.0f / 64.0f) + NORM_EPS) ;
                    f32x4 v[2][2];
#pragma unroll
                    for (int bj = 0; bj < 2; ++bj)
#pragma unroll
                        for (int n = 0; n < 2; ++n) v[bj][n] = acc[ai][bj][m][n] * rinv * gv[bj][n];
#pragma unroll
                    for (int n = 0; n < 2; ++n) {
                        const f32x4 cs = tcs[n], sn = tsn[n];
                        f32x4 pr;
#pragma unroll
                        for (int e = 0; e < 4; ++e) pr[e] = __shfl_xor(v[0][n][e], 16);
                        if (fq < 2) {
#pragma unroll
                            for (int e = 0; e < 4; ++e) v[0][n][e] = (fq == 0) ? (v[0][n][e] * cs[e] - pr[e] * sn[e]) : (v[0][n][e] * cs[e] + pr[e] * sn[e]);
                        }
                    }
                    bf16_t* rowp = outp + (size_t)row * 1024 + 8 * fq;
#pragma unroll
                    for (int bj = 0; bj < 2; ++bj) { const f32x4 a = v[bj][0], b = v[bj][1]; u32x4 w; w.x = cvtpk(a[0], a[1]); w.y = cvtpk(a[2], a[3]); w.z = cvtpk(b[0], b[1]); w.w = cvtpk(b[2], b[3]);
                        *(u32x4*)(rowp + 32 * bj) = w; }
#pragma unroll
                    for (int n = 0; n < 2; ++n) { tcs[n] = ncs[n]; tsn[n] = nsn[n]; }
                }
        } else if (c0 < C_CQ) {
#pragma unroll
            for (int ai = 0; ai < 2; ++ai)
#pragma unroll
                for (int m = 0; m < 4; ++m) { bf16_t* rowp = dav + (size_t)(rbase + ai * 128 + m * 16) * 1024 + (c0 - C_V) + 8 * fq;
#pragma unroll
                    for (int bj = 0; bj < 2; ++bj) { const f32x4 a = acc[ai][bj][m][0], b = acc[ai][bj][m][1]; u32x4 w; w.x = cvtpk(a[0], a[1]); w.y = cvtpk(a[2], a[3]); w.z = cvtpk(b[0], b[1]); w.w = cvtpk(b[2], b[3]);
                        *(u32x4*)(rowp + 32 * bj) = w; } }
        } else if (c0 < C_KR) {
            const bool iscq = c0 < C_CKV; const int cc = iscq ? (c0 - C_CQ) : (c0 - C_CKV); const int ld = iscq ? QLORA : KVLORA;
            bf16_t* outp = (iscq ? cq : ckv) + cc; const int sidx = iscq ? (cc >> 6) : (8 + (cc >> 6));
#pragma unroll
            for (int ai = 0; ai < 2; ++ai)
#pragma unroll
                for (int m = 0; m < 4; ++m) { const int row = rbase + ai * 128 + m * 16; bf16_t* rowp = outp + (size_t)row * ld + 8 * fq; float ss = 0.f;
#pragma unroll
                    for (int bj = 0; bj < 2; ++bj) { const f32x4 a = acc[ai][bj][m][0], b = acc[ai][bj][m][1];
                        ss += (a[0] * a[0] + a[1] * a[1]) + (a[2] * a[2] + a[3] * a[3]) + (b[0] * b[0] + b[1] * b[1]) + (b[2] * b[2] + b[3] * b[3]);
                        u32x4 w; w.x = cvtpk(a[0], a[1]); w.y = cvtpk(a[2], a[3]); w.z = cvtpk(b[0], b[1]); w.w = cvtpk(b[2], b[3]);
                        *(u32x4*)(rowp + 32 * bj) = w; }
                    ss += __shfl_xor(ss, 16); ss += __shfl_xor(ss, 32);
                    if (fq == 0) ssq[(size_t)row * 16 + sidx] = ss; }
        } else if (c0 == C_KR) {
            f32x4 gv[2][2];
#pragma unroll
            for (int bj = 0; bj < 2; ++bj)
#pragma unroll
                for (int n = 0; n < 2; ++n) gv[bj][n] = *(const f32x4*)(gkr + 32 * bj + 8 * fq + 4 * n);
#pragma unroll
            for (int ai = 0; ai < 2; ++ai)
#pragma unroll
                for (int m = 0; m < 4; ++m) {
                    const int row = rbase + ai * 128 + m * 16;
                    float ss = 0.f;
#pragma unroll
                    for (int bj = 0; bj < 2; ++bj)
#pragma unroll
                        for (int n = 0; n < 2; ++n) { const f32x4 v = acc[ai][bj][m][n]; ss += (v[0] * v[0] + v[1] * v[1]) + (v[2] * v[2] + v[3] * v[3]); }
                    ss += __shfl_xor(ss, 16); ss += __shfl_xor(ss, 32);
                    const float rinv = __builtin_amdgcn_rsqf(ss * (1.0f / 64.0f) + NORM_EPS);
                    const float* rt = rope_ml + (size_t)row * 64 + 8 * fq;
                    bf16_t* rowp = krope + (size_t)row * 64 + 8 * fq;
                    f32x4 o1[2], o2[2];
#pragma unroll
                    for (int n = 0; n < 2; ++n) { const f32x4 cs = *(const f32x4*)(rt + 4 * n), sn = *(const f32x4*)(rt + 32 + 4 * n);
                        const f32x4 x1 = acc[ai][0][m][n] * rinv * gv[0][n], x2 = acc[ai][1][m][n] * rinv * gv[1][n];
                        o1[n] = x1 * cs - x2 * sn; o2[n] = x2 * cs + x1 * sn; }
                    u32x4 w; w.x = cvtpk(o1[0][0], o1[0][1]); w.y = cvtpk(o1[0][2], o1[0][3]); w.z = cvtpk(o1[1][0], o1[1][1]); w.w = cvtpk(o1[1][2], o1[1][3]);
                    *(u32x4*)(rowp) = w;
                    w.x = cvtpk(o2[0][0], o2[0][1]); w.y = cvtpk(o2[0][2], o2[0][3]); w.z = cvtpk(o2[1][0], o2[1][1]); w.w = cvtpk(o2[1][2], o2[1][3]);
                    *(u32x4*)(rowp + 32) = w;
                }
        } else if (c0 >= C_G) {
            const int gc = c0 - C_G;
            f32x4 bv[2][2];
#pragma unroll
            for (int bj = 0; bj < 2; ++bj)
#pragma unroll
                for (int n = 0; n < 2; ++n) bv[bj][n] = *(const f32x4*)(bgate + gc + 32 * bj + 8 * fq + 4 * n) * (-LOG2E);
#pragma unroll
            for (int ai = 0; ai < 2; ++ai)
#pragma unroll
                for (int m = 0; m < 4; ++m) { unsigned char* rowp = gates + (size_t)(rbase + ai * 128 + m * 16) * 2048 + gc + 8 * fq;
#pragma unroll
                    for (int bj = 0; bj < 2; ++bj) { const f32x4 a = acc[ai][bj][m][0] * (-LOG2E) + bv[bj][0], b = acc[ai][bj][m][1] * (-LOG2E) + bv[bj][1]; u32x2 w = {0u, 0u};
#define SG2(x_) __builtin_floorf(__builtin_amdgcn_rcpf(1.0f + __builtin_amdgcn_exp2f(x_)) * 255.0f + 0.5f)
#pragma unroll
                        for (int e = 0; e < 4; ++e) { w.x = __builtin_amdgcn_cvt_pk_u8_f32(SG2(a[e]), e, w.x); w.y = __builtin_amdgcn_cvt_pk_u8_f32(SG2(b[e]), e, w.y); }
#undef SG2
                        *(u32x2*)(rowp + 32 * bj) = w; } }
        }
    }
};

struct EpiMlaQ {
    static constexpr int MODE = 1; static constexpr bool SIGNAL = false;
    bf16_t* mq; const float* ssq;
    __device__ __forceinline__ void operator()(const Acc& acc, const Unit& u, int wr, int wc, int fr, int fq, LAS unsigned char*) const {
        const int rbase = u.pm * 256 + wr * 64 + fr; const int col0 = u.pn * 256 + wc * 32 + 8 * fq;
        float rinvs[2][4];
#pragma unroll
        for (int ai = 0; ai < 2; ++ai)
#pragma unroll
            for (int m = 0; m < 4; ++m) { const size_t row = (size_t)(rbase + ai * 128 + m * 16);
                const f32x4 s4 = *(const f32x4*)(ssq + row * 16); const f32x2 s2 = *(const f32x2*)(ssq + row * 16 + 4);
                rinvs[ai][m] = __builtin_amdgcn_rsqf(((s4[0] + s4[1]) + (s4[2] + s4[3]) + (s2[0] + s2[1])) * (1.0f / 384.0f) + NORM_EPS); }
#pragma unroll
        for (int ai = 0; ai < 2; ++ai)
#pragma unroll
            for (int m = 0; m < 4; ++m) { const int row = rbase + ai * 128 + m * 16;
                const float rinv = rinvs[ai][m];
                bf16_t* rowp = mq + (size_t)row * MQ_N + col0;
#pragma unroll
                for (int bj = 0; bj < 2; ++bj) { const f32x4 a = acc[ai][bj][m][0] * rinv, b = acc[ai][bj][m][1] * rinv; u32x4 w; w.x = cvtpk(a[0], a[1]); w.y = cvtpk(a[2], a[3]); w.z = cvtpk(b[0], b[1]); w.w = cvtpk(b[2], b[3]);
                    *(u32x4*)(rowp + 128 * bj) = w; } }
    }
};

struct EpiMlaKV {
    static constexpr int MODE = 2; static constexpr bool SIGNAL = false;
    bf16_t* mkv; const float* ssq; const float* gkn;
    __device__ __forceinline__ void operator()(const Acc& acc, const Unit& u, int wr, int wc, int fr, int fq, LAS unsigned char* lds) const {
        LAS float* X = (LAS float*)(lds + EXCH_OFF);
        const int rl = wr * 64 + fr; const int rbase = u.pm * 256 + rl;
        float rinv[2][4];
#pragma unroll
        for (int ai = 0; ai < 2; ++ai)
#pragma unroll
            for (int m = 0; m < 4; ++m) { const f32x4 s4 = *(const f32x4*)(ssq + (size_t)(rbase + ai * 128 + m * 16) * 16 + 8);
                rinv[ai][m] = __builtin_amdgcn_rsqf(((s4[0] + s4[1]) + (s4[2] + s4[3])) * (1.0f / 256.0f) + NORM_EPS); }
        if (wc < 2) {
#pragma unroll
            for (int ai = 0; ai < 2; ++ai)
#pragma unroll
                for (int m = 0; m < 4; ++m) { float ss = 0.f;
#pragma unroll
                    for (int bj = 0; bj < 2; ++bj)
#pragma unroll
                        for (int n = 0; n < 2; ++n) { const f32x4 v = acc[ai][bj][m][n] * rinv[ai][m]; ss += (v[0] * v[0] + v[1] * v[1]) + (v[2] * v[2] + v[3] * v[3]); }
                    ss += __shfl_xor(ss, 16); ss += __shfl_xor(ss, 32);
                    if (fq == 0) X[(rl + ai * 128 + m * 16) * 2 + wc] = ss; }
        }
        asm volatile("s_waitcnt lgkmcnt(0)\n\ts_barrier" ::: "memory");
        f32x4 gv[2][2];
#pragma unroll
        for (int bj = 0; bj < 2; ++bj)
#pragma unroll
            for (int n = 0; n < 2; ++n) gv[bj][n] = (wc < 2) ? *(const f32x4*)(gkn + 64 * wc + 32 * bj + 8 * fq + 4 * n) : (f32x4){1.f, 1.f, 1.f, 1.f};
#pragma unroll
        for (int ai = 0; ai < 2; ++ai)
#pragma unroll
            for (int m = 0; m < 4; ++m) { float sc = rinv[ai][m];
                if (wc < 2) { const f32x2 t = *(const LAS f32x2*)(X + (rl + ai * 128 + m * 16) * 2); sc *= __builtin_amdgcn_rsqf((t[0] + t[1]) * (1.0f / 128.0f) + NORM_EPS); }
                bf16_t* rowp = mkv + (size_t)(rbase + ai * 128 + m * 16) * MKV_N + u.pn * 256 + wc * 64 + 8 * fq;
#pragma unroll
                for (int bj = 0; bj < 2; ++bj) { const f32x4 a = acc[ai][bj][m][0] * sc * gv[bj][0], b = acc[ai][bj][m][1] * sc * gv[bj][1]; u32x4 w; w.x = cvtpk(a[0], a[1]); w.y = cvtpk(a[2], a[3]); w.z = cvtpk(b[0], b[1]); w.w = cvtpk(b[2], b[3]);
                    *(u32x4*)(rowp + 32 * bj) = w; } }
    }
};

struct EpiOut {
    static constexpr int MODE = 1; static constexpr bool SIGNAL = false;
    const float* x; bf16_t* x1;
    __device__ __forceinline__ void operator()(const Acc& acc, const Unit& u, int wr, int wc, int fr, int fq, LAS unsigned char*) const {
        const int col0 = u.pn * 256 + wc * 32 + 8 * fq;
#pragma unroll
        for (int ai = 0; ai < 2; ++ai) {
            f32x4 res[4][2][2];
#pragma unroll
            for (int m = 0; m < 4; ++m) { const size_t off = (size_t)(u.pm * 256 + ai * 128 + wr * 64 + m * 16 + fr) * DM + col0;
#pragma unroll
                for (int bj = 0; bj < 2; ++bj)
#pragma unroll
                    for (int n = 0; n < 2; ++n) res[m][bj][n] = *(const f32x4*)(x + off + bj * 128 + n * 4); }
#pragma unroll
            for (int m = 0; m < 4; ++m) { const size_t off = (size_t)(u.pm * 256 + ai * 128 + wr * 64 + m * 16 + fr) * DM + col0;
#pragma unroll
                for (int bj = 0; bj < 2; ++bj) { const f32x4 a = res[m][bj][0] + acc[ai][bj][m][0], b = res[m][bj][1] + acc[ai][bj][m][1];
                    u32x4 w; w.x = cvtpk(a[0], a[1]); w.y = cvtpk(a[2], a[3]); w.z = cvtpk(b[0], b[1]); w.w = cvtpk(b[2], b[3]);
                    *(u32x4*)(x1 + off + bj * 128) = w; } }
        }
    }
};

struct EpiSwiglu {
    static constexpr int MODE = 1; static constexpr bool SIGNAL = true;
    bf16_t* he; unsigned* done;
    __device__ __forceinline__ void operator()(const Acc& acc, const Unit& u, int wr, int wc, int fr, int fq, LAS unsigned char*) const {
        const int voff = (fr * DEXP + 8 * fq) * 2;
#pragma unroll
        for (int ai = 0; ai < 2; ++ai)
#pragma unroll
            for (int m = 0; m < 4; ++m) { const int soff = __builtin_amdgcn_readfirstlane(((u.pm * 256 + ai * 128 + wr * 64 + m * 16) * DEXP + u.pn * 128 + wc * 32) * 2);
                f32x4 h[2];
#pragma unroll
                for (int n = 0; n < 2; ++n) { const f32x4 a = acc[ai][0][m][n], b = acc[ai][1][m][n];
#pragma unroll
                    for (int e = 0; e < 4; ++e) h[n][e] = a[e] * sigmoidf_fast(a[e]) * b[e]; }
                u32x4 w; w.x = cvtpk(h[0][0], h[0][1]); w.y = cvtpk(h[0][2], h[0][3]); w.z = cvtpk(h[1][0], h[1][1]); w.w = cvtpk(h[1][2], h[1][3]);
                { u32x4* gp_ = (u32x4*)((char*)he + (size_t)(unsigned)soff + voff); asm volatile("global_store_dwordx4 %0, %1, off sc1\n\ts_nop 2" :: "v"(gp_), "v"(w) : "memory"); } }
    }
};

struct EpiDown {
    static constexpr int MODE = 1; static constexpr bool SIGNAL = false;
    bf16_t* y; const int* row_slot; const float* row_w;
    __device__ __forceinline__ void operator()(const Acc& acc, const Unit& u, int wr, int wc, int fr, int fq, LAS unsigned char*) const {
        int slots[2][4]; float wgts[2][4];
#pragma unroll
        for (int ai = 0; ai < 2; ++ai)
#pragma unroll
            for (int m = 0; m < 4; ++m) { const int prow = u.pm * 256 + ai * 128 + wr * 64 + m * 16 + fr; slots[ai][m] = row_slot[prow]; wgts[ai][m] = row_w[prow]; }
#pragma unroll
        for (int ai = 0; ai < 2; ++ai)
#pragma unroll
            for (int m = 0; m < 4; ++m) { const int slot = slots[ai][m]; const float wgt = wgts[ai][m];
                if (slot >= 0) { bf16_t* rowp = y + (size_t)slot * DM + u.pn * 256 + wc * 32 + 8 * fq;
#pragma unroll
                    for (int bj = 0; bj < 2; ++bj) { const f32x4 a = acc[ai][bj][m][0] * wgt, b = acc[ai][bj][m][1] * wgt; u32x4 w; w.x = cvtpk(a[0], a[1]); w.y = cvtpk(a[2], a[3]); w.z = cvtpk(b[0], b[1]); w.w = cvtpk(b[2], b[3]);
                        *(u32x4*)(rowp + 128 * bj) = w; } } }
    }
};
}

namespace att {
#define SBAR() __builtin_amdgcn_sched_barrier(0)
typedef LAS const char* lds_cptr;
typedef short v4i16_t __attribute__((ext_vector_type(4)));
constexpr int SLOT_DA = 32768, SLOT_ML = 40960;
constexpr float THRL = 8.0f;
__device__ __forceinline__ int crow(int r, int hi) { return (r & 3) + 8 * (r >> 2) + 4 * hi; }
__device__ __forceinline__ void glds16(const void* gsrc, unsigned lds_dst) { unsigned keep;
    asm volatile("s_mov_b32 %0, m0\n\ts_mov_b32 m0, %2\n\ts_nop 0\n\tglobal_load_lds_dwordx4 %1, off\n\ts_mov_b32 m0, %0" : "=&s"(keep) : "v"(gsrc), "s"(lds_dst) : "memory"); }
__device__ __forceinline__ s16x4 vtr(lds_cptr p) { return __builtin_bit_cast(s16x4, __builtin_amdgcn_ds_read_tr16_b64_v4i16((LAS v4i16_t*)p)); }
__device__ __forceinline__ float swap_max(float v) { auto rr = __builtin_amdgcn_permlane32_swap(__float_as_uint(v), __float_as_uint(v), false, false); return fmaxf(__uint_as_float(rr[0]), __uint_as_float(rr[1])); }
__device__ __forceinline__ float swap_add(float v) { auto rr = __builtin_amdgcn_permlane32_swap(__float_as_uint(v), __float_as_uint(v), false, false); return __uint_as_float(rr[0]) + __uint_as_float(rr[1]); }
#define WAIT_BAR(N) asm volatile("s_waitcnt vmcnt(" #N ") lgkmcnt(0)\n\ts_barrier" ::: "memory")

template <int NQF>
__device__ __forceinline__ void qk_softmax(const bf16x8 (&qf)[NQF], unsigned ka, unsigned kr, f32x16 (&o)[4], f32x16& negm, float& m_run, float& l_run, bool& first, LAS float* wsf,
                                           int r32, int hi, bool need_mask, int qg, int k0, int var, u32x4 (&pw)[4]) {
    f32x16 p0, p1;
#define KLD(dst, d0_) do { const unsigned a_ = ((d0_) < 8) ? (ka ^ (unsigned)((d0_) << 5)) : (kr ^ (unsigned)(((d0_) - 8) << 5)); \
        dst[0] = *(const LAS bf16x8*)(uintptr_t)a_; dst[1] = *(const LAS bf16x8*)(uintptr_t)(a_ + ((d0_) < 8 ? 8192u : 4096u)); } while (0)
#if PROBE_VARIANTS
    if (var & 4) { p0 = negm; p1 = negm; asm volatile("" : "+v"(p0), "+v"(p1)); } else
#endif
    if constexpr (NQF == 4) {
        bf16x8 kf[4][2];
#pragma unroll
        for (int d0 = 0; d0 < 4; ++d0) KLD(kf[d0], d0);
        SBAR();
        __builtin_amdgcn_s_setprio(1);
        p0 = __builtin_amdgcn_mfma_f32_32x32x16_bf16(kf[0][0], qf[0], negm, 0, 0, 0); p1 = __builtin_amdgcn_mfma_f32_32x32x16_bf16(kf[0][1], qf[0], negm, 0, 0, 0);
#pragma unroll
        for (int d0 = 1; d0 < 4; ++d0) { p0 = __builtin_amdgcn_mfma_f32_32x32x16_bf16(kf[d0][0], qf[d0], p0, 0, 0, 0); p1 = __builtin_amdgcn_mfma_f32_32x32x16_bf16(kf[d0][1], qf[d0], p1, 0, 0, 0); }
        __builtin_amdgcn_s_setprio(0);
    } else {
        bf16x8 kA[2][2], kB[2][2];
        KLD(kA[0], 0); KLD(kA[1], 1); SBAR();
#pragma unroll
        for (int g = 0; g < NQF / 2; g += 2) {
            if (g + 1 < NQF / 2) { KLD(kB[0], 2 * g + 2); KLD(kB[1], 2 * g + 3); } SBAR();
            if (g == 0) { p0 = __builtin_amdgcn_mfma_f32_32x32x16_bf16(kA[0][0], qf[0], negm, 0, 0, 0); p1 = __builtin_amdgcn_mfma_f32_32x32x16_bf16(kA[0][1], qf[0], negm, 0, 0, 0); }
            else { p0 = __builtin_amdgcn_mfma_f32_32x32x16_bf16(kA[0][0], qf[2 * g], p0, 0, 0, 0); p1 = __builtin_amdgcn_mfma_f32_32x32x16_bf16(kA[0][1], qf[2 * g], p1, 0, 0, 0); }
            p0 = __builtin_amdgcn_mfma_f32_32x32x16_bf16(kA[1][0], qf[2 * g + 1], p0, 0, 0, 0); p1 = __builtin_amdgcn_mfma_f32_32x32x16_bf16(kA[1][1], qf[2 * g + 1], p1, 0, 0, 0);
            SBAR();
            if (g + 1 < NQF / 2) {
                if (g + 2 < NQF / 2) { KLD(kA[0], 2 * g + 4); KLD(kA[1], 2 * g + 5); } SBAR();
                p0 = __builtin_amdgcn_mfma_f32_32x32x16_bf16(kB[0][0], qf[2 * g + 2], p0, 0, 0, 0); p1 = __builtin_amdgcn_mfma_f32_32x32x16_bf16(kB[0][1], qf[2 * g + 2], p1, 0, 0, 0);
                p0 = __builtin_amdgcn_mfma_f32_32x32x16_bf16(kB[1][0], qf[2 * g + 3], p0, 0, 0, 0); p1 = __builtin_amdgcn_mfma_f32_32x32x16_bf16(kB[1][1], qf[2 * g + 3], p1, 0, 0, 0);
                SBAR();
            }
        }
    }
#undef KLD
#if PROBE_VARIANTS
    if (!(var & 2))
#endif
    {
    if (need_mask) {
        const float NEG = -__builtin_inff(); const int kb = k0 + 4 * hi;
#pragma unroll
        for (int r = 0; r < 16; ++r) { const int kv = kb + (r & 3) + 8 * (r >> 2); if (kv > qg) p0[r] = NEG; if (kv + 32 > qg) p1[r] = NEG; }
    }
#pragma unroll
    for (int r = 0; r < 16; ++r) { __builtin_assume(p0[r] == p0[r]); __builtin_assume(p1[r] == p1[r]); }
    float mxa = __builtin_fmaxf(__builtin_fmaxf(p0[0], p0[1]), p1[0]), mxb = __builtin_fmaxf(__builtin_fmaxf(p0[2], p0[3]), p1[1]);
    mxa = __builtin_fmaxf(__builtin_fmaxf(mxa, p1[2]), p1[3]);
#pragma unroll
    for (int r = 4; r < 16; r += 4) { mxa = __builtin_fmaxf(__builtin_fmaxf(mxa, p0[r]), p0[r + 1]); mxb = __builtin_fmaxf(__builtin_fmaxf(mxb, p0[r + 2]), p0[r + 3]);
        mxa = __builtin_fmaxf(__builtin_fmaxf(mxa, p1[r]), p1[r + 1]); mxb = __builtin_fmaxf(__builtin_fmaxf(mxb, p1[r + 2]), p1[r + 3]); }
    float mx = swap_max(__builtin_fmaxf(mxa, mxb));
    if (__any(first || mx > THRL)) {
        const float dl = first ? mx : __builtin_fmaxf(mx, 0.f);
        m_run += dl;
#pragma unroll
        for (int r = 0; r < 16; ++r) { p0[r] -= dl; p1[r] -= dl; }
#pragma unroll
        for (int r = 0; r < 16; ++r) negm[r] = -m_run;
        if (!first) {
            const float alpha = __builtin_amdgcn_exp2f(-dl); l_run *= alpha;
            if (hi == 0) wsf[r32] = alpha;
#pragma unroll
            for (int g = 0; g < 4; ++g) { const f32x4 a4 = *(const LAS f32x4*)(wsf + 8 * g + 4 * hi);
#pragma unroll
                for (int d = 0; d < 4; ++d)
#pragma unroll
                    for (int e = 0; e < 4; ++e) o[d][4 * g + e] *= a4[e]; }
        }
        first = false;
    }
    float ps = 0.f;
#pragma unroll
    for (int r = 0; r < 16; ++r) { p0[r] = __builtin_amdgcn_exp2f(p0[r]); p1[r] = __builtin_amdgcn_exp2f(p1[r]); ps += p0[r] + p1[r]; }
    l_run += ps;
    }
    pw[0].x = cvtpk(p0[0], p0[1]); pw[0].y = cvtpk(p0[2], p0[3]); pw[0].z = cvtpk(p0[4], p0[5]); pw[0].w = cvtpk(p0[6], p0[7]);
    pw[1].x = cvtpk(p0[8], p0[9]); pw[1].y = cvtpk(p0[10], p0[11]); pw[1].z = cvtpk(p0[12], p0[13]); pw[1].w = cvtpk(p0[14], p0[15]);
    pw[2].x = cvtpk(p1[0], p1[1]); pw[2].y = cvtpk(p1[2], p1[3]); pw[2].z = cvtpk(p1[4], p1[5]); pw[2].w = cvtpk(p1[6], p1[7]);
    pw[3].x = cvtpk(p1[8], p1[9]); pw[3].y = cvtpk(p1[10], p1[11]); pw[3].z = cvtpk(p1[12], p1[13]); pw[3].w = cvtpk(p1[14], p1[15]);
}

__device__ __forceinline__ void pv_tile(const u32x4 (&pw)[4], unsigned va, f32x16 (&o)[4], int var) {
    const bf16x8 pa0 = __builtin_bit_cast(bf16x8, pw[0]), pa1 = __builtin_bit_cast(bf16x8, pw[1]), pa2 = __builtin_bit_cast(bf16x8, pw[2]), pa3 = __builtin_bit_cast(bf16x8, pw[3]);
#if PROBE_VARIANTS
    if (var & 8) { asm volatile("" :: "v"(pa0), "v"(pa1), "v"(pa2), "v"(pa3)); return; }
#endif
    s16x4 loA[4], hhA[4], loB[4], hhB[4];
#define VLD(L, H, d_) do { const lds_cptr vp_ = (lds_cptr)(uintptr_t)(va ^ (unsigned)((d_) << 6)); \
        _Pragma("unroll") for (int ks = 0; ks < 4; ++ks) { L[ks] = vtr(vp_ + ks * 4096); H[ks] = vtr(vp_ + ks * 4096 + 2048); } } while (0)
#define PKV(L, H, k) (bf16x8){L[k][0], L[k][1], L[k][2], L[k][3], H[k][0], H[k][1], H[k][2], H[k][3]}
#define PVMM(L, H, d_) do { __builtin_amdgcn_s_setprio(1); o[d_] = __builtin_amdgcn_mfma_f32_32x32x16_bf16(pa0, PKV(L, H, 0), o[d_], 0, 0, 0); o[d_] = __builtin_amdgcn_mfma_f32_32x32x16_bf16(pa1, PKV(L, H, 1), o[d_], 0, 0, 0); \
        o[d_] = __builtin_amdgcn_mfma_f32_32x32x16_bf16(pa2, PKV(L, H, 2), o[d_], 0, 0, 0); o[d_] = __builtin_amdgcn_mfma_f32_32x32x16_bf16(pa3, PKV(L, H, 3), o[d_], 0, 0, 0); __builtin_amdgcn_s_setprio(0); } while (0)
    VLD(loA, hhA, 0);
    SBAR(); VLD(loB, hhB, 1); SBAR(); PVMM(loA, hhA, 0);
    SBAR(); VLD(loA, hhA, 2); SBAR(); PVMM(loB, hhB, 1);
    SBAR(); VLD(loB, hhB, 3); SBAR(); PVMM(loA, hhA, 2);
    SBAR(); PVMM(loB, hhB, 3);
#undef PVMM
#undef PKV
#undef VLD
}

struct AttnP { const bf16_t *daq, *dak, *dav, *mq, *mkv, *krope; const unsigned char* gates; bf16_t* mixed; const float *subln_g, *mla_qg, *rope_ml; float lam; bool dry; int var; };

__device__ __forceinline__ void stage_o(f32x16 (&o)[4], float l_run, LAS float* wsf, LAS float* stg, int r32, int hi) {
    const float linv = 1.0f / swap_add(l_run);
    if (hi == 0) wsf[r32] = linv;
#pragma unroll
    for (int g = 0; g < 4; ++g) { const f32x4 a4 = *(const LAS f32x4*)(wsf + 8 * g + 4 * hi);
#pragma unroll
        for (int d = 0; d < 4; ++d)
#pragma unroll
            for (int e = 0; e < 4; ++e) stg[(8 * g + 4 * hi + e) * STAGE_ROW + 32 * d + r32] = o[d][4 * g + e] * a4[e]; }
}

__device__ __forceinline__ void da_sub(const AttnP& P, int b, int h, int q0, bool swapmaps, char* shm) {
    int tid_ = threadIdx.x; asm volatile("" : "+v"(tid_));
    const int tid = tid_, lane = tid & 63, r32 = lane & 31, hi = lane >> 5; const int wid = __builtin_amdgcn_readfirstlane(tid >> 6);
    const int map = swapmaps ? 1 - (wid >> 2) : (wid >> 2);
    const int qw = q0 + 32 * (wid & 3);
    const size_t tok0 = (size_t)b * SEQ;
    const unsigned lds0 = (unsigned)(uintptr_t)shm;
    const lds_cptr shm3 = (lds_cptr)shm;
    LAS float* wsf = (LAS float*)(shm3 + WSF_OFF) + wid * 64;
    const int NT = (q0 + 128) / 64;
    const int dkey = 4 * wid + (lane >> 4), dpos = lane & 15;
    const bf16_t* ksrc = P.dak + (tok0 + dkey) * 1024 + h * 128 + ((dpos ^ (dkey & 15)) << 3);
    const bf16_t* vsrc = P.dav + (tok0 + dkey) * 1024 + h * 128 + ((dpos ^ ((dkey & 3) << 2)) << 3);
#define DMA_TILE(t, ks_, vs_) do { const unsigned k_ = (unsigned)__builtin_amdgcn_readfirstlane(lds0 + (ks_)), v_ = (unsigned)__builtin_amdgcn_readfirstlane(lds0 + (vs_)); const size_t ro_ = (size_t)(t) * 64 * 1024; \
        glds16(ksrc + ro_, k_ + wid * 1024); glds16(ksrc + ro_ + 32 * 1024, k_ + (wid + 8) * 1024); \
        glds16(vsrc + ro_, v_ + wid * 1024); glds16(vsrc + ro_ + 32 * 1024, v_ + (wid + 8) * 1024); } while (0)
    constexpr int KR0 = 0, KSZ = 16384, VR0 = 49152, VSZ = 16384;
    DMA_TILE(0, KR0, VR0); DMA_TILE(1, KR0 + KSZ, VR0 + VSZ);
    bf16x8 qf[4];
    { const bf16_t* qp = P.daq + (tok0 + qw + r32) * 1024 + h * 128 + 64 * map + 8 * hi;
#pragma unroll
      for (int d0 = 0; d0 < 4; ++d0) qf[d0] = *(const bf16x8*)(qp + 16 * d0); }
    f32x16 o[4]; o[0] = f32x16{}; o[1] = f32x16{}; o[2] = f32x16{}; o[3] = f32x16{};
    float m_run = 0.f, l_run = 0.f; bool first = true; f32x16 negm = f32x16{};
    const unsigned koff = (unsigned)(r32 * 256 + (((8 * map + hi) ^ (r32 & 15)) << 4));
    const int vq = (lane & 15) >> 2;
    const unsigned voff = (unsigned)((4 * hi + vq) * 256 + (vq << 6) + ((((lane >> 4) & 1) * 2 + ((lane & 3) >> 1)) << 4) + ((lane & 1) << 3));
    const int qg = qw + r32;
    const bool defer = wid >= 4;
    u32x4 pw[4]; bool pend = false; unsigned va_pend = 0;
    int kc = KR0, kn = KR0 + KSZ, knn = KR0 + 2 * KSZ;
    int vc = VR0, vnn = VR0 + 2 * VSZ;
    for (int t = 0; t < NT; ++t) {
#if PROBE_VARIANTS
        if (P.var & 16) { asm volatile("s_waitcnt vmcnt(0) lgkmcnt(0)" ::: "memory"); } else
#endif
        { if (t + 1 < NT) WAIT_BAR(4); else WAIT_BAR(0); }
        if (t + 2 < NT && !(PROBE_VARIANTS && (P.var & 1))) DMA_TILE(t + 2, knn, vnn);
        if (pend) { pv_tile(pw, va_pend, o, P.var); pend = false; }
        if (64 * t <= qw + 31) {
            qk_softmax<4>(qf, lds0 + kc + koff, 0u, o, negm, m_run, l_run, first, wsf, r32, hi, 64 * t + 63 > qw, qg, 64 * t, P.var, pw);
            if (defer) { pend = true; va_pend = lds0 + vc + voff; } else pv_tile(pw, lds0 + vc + voff, o, P.var);
        }
        { const int tmp = kc; kc = kn; kn = knn; knn = tmp; }
        vc = (vc == VR0 + 3 * VSZ) ? VR0 : vc + VSZ; vnn = (vnn == VR0 + 3 * VSZ) ? VR0 : vnn + VSZ;
    }
    if (pend) pv_tile(pw, va_pend, o, P.var);
#undef DMA_TILE
    WAIT_BAR(0);
    LAS float* stg = (LAS float*)shm3 + wid * (OSTG_BYTES / 4);
    stage_o(o, l_run, wsf, stg, r32, hi);
    WAIT_BAR(0);
    if (map == 0) {
        const LAS float* sp = (const LAS float*)shm3 + (wid ^ 4) * (OSTG_BYTES / 4);
        const int row = lane & 31, half = lane >> 5;
        f32x4 dv[16]; float ss = 0.f;
#pragma unroll
        for (int i = 0; i < 16; ++i) { const f32x4 a = *(const LAS f32x4*)(stg + row * STAGE_ROW + 64 * half + 4 * i), c = *(const LAS f32x4*)(sp + row * STAGE_ROW + 64 * half + 4 * i);
            dv[i] = a - c * P.lam; ss += (dv[i][0] * dv[i][0] + dv[i][1] * dv[i][1]) + (dv[i][2] * dv[i][2] + dv[i][3] * dv[i][3]); }
        ss += __shfl_xor(ss, 32);
        const float rinv = __builtin_amdgcn_rsqf(ss * (1.0f / 128.0f) + NORM_EPS) * ((1.0f - LAMBDA_INIT) / 255.0f);
        const size_t tok = tok0 + qw + row;
        const unsigned char* gp = P.gates + tok * 2048 + h * 128 + 64 * half; bf16_t* op = P.mixed + tok * 1024 + h * 128 + 64 * half; const float* sg = P.subln_g + 64 * half;
        u32x4 gwv[4]; f32x4 sgv[16];
#pragma unroll
        for (int i = 0; i < 4; ++i) gwv[i] = *(const u32x4*)(gp + 16 * i);
#pragma unroll
        for (int i = 0; i < 8; ++i) { sgv[2 * i] = *(const f32x4*)(sg + 8 * i); sgv[2 * i + 1] = *(const f32x4*)(sg + 8 * i + 4); }
#pragma unroll
        for (int i = 0; i < 8; ++i) { const unsigned ga = gwv[i >> 1][2 * (i & 1)], gc = gwv[i >> 1][2 * (i & 1) + 1]; const f32x4 g0 = sgv[2 * i], g1 = sgv[2 * i + 1];
            const f32x4 a = dv[2 * i] * g0 * rinv, c = dv[2 * i + 1] * g1 * rinv; u32x4 w;
            w.x = cvtpk(a[0] * UB(ga, 0), a[1] * UB(ga, 1)); w.y = cvtpk(a[2] * UB(ga, 2), a[3] * UB(ga, 3));
            w.z = cvtpk(c[0] * UB(gc, 0), c[1] * UB(gc, 1)); w.w = cvtpk(c[2] * UB(gc, 2), c[3] * UB(gc, 3));
            if (!P.dry) *(u32x4*)(op + 8 * i) = w; }
    }
    WAIT_BAR(0);
}

__device__ __forceinline__ void mla_unit(const AttnP& P, int b, int h, int q0, char* shm) {
    int tid_ = threadIdx.x; asm volatile("" : "+v"(tid_));
    const int tid = tid_, lane = tid & 63, r32 = lane & 31, hi = lane >> 5; const int wid = __builtin_amdgcn_readfirstlane(tid >> 6);
    const int qw = q0 + 32 * wid;
    const size_t tok0 = (size_t)b * SEQ;
    const unsigned lds0 = (unsigned)(uintptr_t)shm;
    const lds_cptr shm3 = (lds_cptr)shm;
    LAS float* wsf = (LAS float*)(shm3 + WSF_OFF) + wid * 64;
    const int NT = (q0 + 256) / 64;
    const int dkey = 4 * wid + (lane >> 4), dpos = lane & 15, rkey = 8 * wid + (lane >> 3);
    const bf16_t* ksrc = P.mkv + (tok0 + dkey) * 2048 + h * 256 + ((dpos ^ (dkey & 15)) << 3);
    const bf16_t* vsrc = P.mkv + (tok0 + dkey) * 2048 + h * 256 + 128 + ((dpos ^ ((dkey & 3) << 2)) << 3);
    const bf16_t* rsrc = P.krope + (tok0 + rkey) * 64 + (((lane & 7) ^ ((rkey >> 1) & 7)) << 3);
#define DMA_TILE(t, ks_, vs_) do { const unsigned k_ = (unsigned)__builtin_amdgcn_readfirstlane(lds0 + (ks_)), v_ = (unsigned)__builtin_amdgcn_readfirstlane(lds0 + (vs_)); const size_t ro_ = (size_t)(t) * 64 * 2048; \
        glds16(ksrc + ro_, k_ + wid * 1024); glds16(ksrc + ro_ + 32 * 2048, k_ + (wid + 8) * 1024); glds16(rsrc + (size_t)(t) * 64 * 64, k_ + 16384 + wid * 1024); \
        glds16(vsrc + ro_, v_ + wid * 1024); glds16(vsrc + ro_ + 32 * 2048, v_ + (wid + 8) * 1024); } while (0)
    constexpr int KR0 = 0, KSZ = 24576, VR0 = 73728, VSZ = 16384;
    DMA_TILE(0, KR0, VR0); DMA_TILE(1, KR0 + KSZ, VR0 + VSZ);
    bf16x8 qf[12];
    { const size_t tok = tok0 + qw + r32; const bf16_t* qp = P.mq + tok * MQ_N + h * 192 + 8 * hi;
      u32x4 raw[12]; float ss = 0.f;
#pragma unroll
      for (int d0 = 0; d0 < 12; ++d0) { raw[d0] = *(const u32x4*)(qp + 16 * d0);
#pragma unroll
          for (int j = 0; j < 4; ++j) { const float a = bf_lo(raw[d0][j]), c = bf_hi(raw[d0][j]); ss += a * a + c * c; } }
      ss += __shfl_xor(ss, 32);
      const float rinv = __builtin_amdgcn_rsqf(ss * (1.0f / 192.0f) + NORM_EPS) * C2_MLA;
      const float* gq = P.mla_qg + 8 * hi; const float* rt = P.rope_ml + tok * 64 + 8 * hi;
#pragma unroll
      for (int d0 = 0; d0 < 8; ++d0) { const f32x4 g0 = *(const f32x4*)(gq + 16 * d0), g1 = *(const f32x4*)(gq + 16 * d0 + 4); u32x4 w;
          w.x = cvtpk(bf_lo(raw[d0].x) * g0[0] * rinv, bf_hi(raw[d0].x) * g0[1] * rinv); w.y = cvtpk(bf_lo(raw[d0].y) * g0[2] * rinv, bf_hi(raw[d0].y) * g0[3] * rinv);
          w.z = cvtpk(bf_lo(raw[d0].z) * g1[0] * rinv, bf_hi(raw[d0].z) * g1[1] * rinv); w.w = cvtpk(bf_lo(raw[d0].w) * g1[2] * rinv, bf_hi(raw[d0].w) * g1[3] * rinv);
          qf[d0] = __builtin_bit_cast(bf16x8, w); }
#pragma unroll
      for (int dd = 0; dd < 2; ++dd) {
          float x1[8], x2[8], c[8], s[8];
          const f32x4 ga0 = *(const f32x4*)(gq + 16 * (8 + dd)), ga1 = *(const f32x4*)(gq + 16 * (8 + dd) + 4), gb0 = *(const f32x4*)(gq + 16 * (10 + dd)), gb1 = *(const f32x4*)(gq + 16 * (10 + dd) + 4);
          const f32x4 c0 = *(const f32x4*)(rt + 16 * dd), c1 = *(const f32x4*)(rt + 16 * dd + 4), s0 = *(const f32x4*)(rt + 32 + 16 * dd), s1 = *(const f32x4*)(rt + 32 + 16 * dd + 4);
#pragma unroll
          for (int j = 0; j < 4; ++j) { x1[2 * j] = bf_lo(raw[8 + dd][j]); x1[2 * j + 1] = bf_hi(raw[8 + dd][j]); x2[2 * j] = bf_lo(raw[10 + dd][j]); x2[2 * j + 1] = bf_hi(raw[10 + dd][j]); }
#pragma unroll
          for (int j = 0; j < 4; ++j) { c[j] = c0[j]; c[4 + j] = c1[j]; s[j] = s0[j]; s[4 + j] = s1[j];
              x1[j] *= ga0[j] * rinv; x1[4 + j] *= ga1[j] * rinv; x2[j] *= gb0[j] * rinv; x2[4 + j] *= gb1[j] * rinv; }
          float y1[8], y2[8];
#pragma unroll
          for (int j = 0; j < 8; ++j) { y1[j] = x1[j] * c[j] - x2[j] * s[j]; y2[j] = x2[j] * c[j] + x1[j] * s[j]; }
          u32x4 w; w.x = cvtpk(y1[0], y1[1]); w.y = cvtpk(y1[2], y1[3]); w.z = cvtpk(y1[4], y1[5]); w.w = cvtpk(y1[6], y1[7]); qf[8 + dd] = __builtin_bit_cast(bf16x8, w);
          w.x = cvtpk(y2[0], y2[1]); w.y = cvtpk(y2[2], y2[3]); w.z = cvtpk(y2[4], y2[5]); w.w = cvtpk(y2[6], y2[7]); qf[10 + dd] = __builtin_bit_cast(bf16x8, w);
      }
    }
    f32x16 o[4]; o[0] = f32x16{}; o[1] = f32x16{}; o[2] = f32x16{}; o[3] = f32x16{};
    float m_run = 0.f, l_run = 0.f; bool first = true; f32x16 negm = f32x16{};
    const unsigned koff = (unsigned)(r32 * 256 + ((hi ^ (r32 & 15)) << 4));
    const unsigned roff = 16384u + (unsigned)(r32 * 128 + ((hi ^ ((r32 >> 1) & 7)) << 4));
    const int vq = (lane & 15) >> 2;
    const unsigned voff = (unsigned)((4 * hi + vq) * 256 + (vq << 6) + ((((lane >> 4) & 1) * 2 + ((lane & 3) >> 1)) << 4) + ((lane & 1) << 3));
    const int qg = qw + r32;
    const bool defer = wid >= 4;
    u32x4 pw[4]; bool pend = false; unsigned va_pend = 0;
    int kc = KR0, kn = KR0 + KSZ, knn = KR0 + 2 * KSZ;
    int vc = VR0, vnn = VR0 + 2 * VSZ;
    for (int t = 0; t < NT; ++t) {
#if PROBE_VARIANTS
        if (P.var & 16) { asm volatile("s_waitcnt vmcnt(0) lgkmcnt(0)" ::: "memory"); } else
#endif
        { if (t + 1 < NT) WAIT_BAR(5); else WAIT_BAR(0); }
        if (t + 2 < NT && !(PROBE_VARIANTS && (P.var & 1))) DMA_TILE(t + 2, knn, vnn);
        if (pend) { pv_tile(pw, va_pend, o, P.var); pend = false; }
        if (64 * t <= qw + 31) {
            qk_softmax<12>(qf, lds0 + kc + koff, lds0 + kc + roff, o, negm, m_run, l_run, first, wsf, r32, hi, 64 * t + 63 > qw, qg, 64 * t, P.var, pw);
            if (defer) { pend = true; va_pend = lds0 + vc + voff; } else pv_tile(pw, lds0 + vc + voff, o, P.var);
        }
        { const int tmp = kc; kc = kn; kn = knn; knn = tmp; }
        vc = (vc == VR0 + 3 * VSZ) ? VR0 : vc + VSZ; vnn = (vnn == VR0 + 3 * VSZ) ? VR0 : vnn + VSZ;
    }
    if (pend) pv_tile(pw, va_pend, o, P.var);
#undef DMA_TILE
    WAIT_BAR(0);
    LAS float* stg = (LAS float*)shm3 + wid * (OSTG_BYTES / 4);
    stage_o(o, l_run, wsf, stg, r32, hi);
    LDS_WAIT();
    {
        const int row = lane & 31, half = lane >> 5; const size_t tok = tok0 + qw + row;
        const unsigned char* gp = P.gates + tok * 2048 + 1024 + h * 128 + 64 * half; bf16_t* op = P.mixed + tok * 1024 + h * 128 + 64 * half;
        u32x4 gwv[4]; unsigned long long st0[8], st1[8];
#pragma unroll
        for (int i = 0; i < 4; ++i) gwv[i] = *(const u32x4*)(gp + 16 * i);
#pragma unroll
        for (int i = 0; i < 8; ++i) {
            st0[i] = __hip_atomic_load((const unsigned long long*)(op + 8 * i), __ATOMIC_RELAXED, __HIP_MEMORY_SCOPE_AGENT);
            st1[i] = __hip_atomic_load((const unsigned long long*)(op + 8 * i + 4), __ATOMIC_RELAXED, __HIP_MEMORY_SCOPE_AGENT); }
#pragma unroll
        for (int i = 0; i < 8; ++i) { const unsigned ga = gwv[i >> 1][2 * (i & 1)], gc = gwv[i >> 1][2 * (i & 1) + 1];
            const unsigned long long s0 = st0[i];
            const unsigned long long s1 = st1[i];
            const unsigned sx = (unsigned)s0, sy = (unsigned)(s0 >> 32), sz = (unsigned)s1, sw = (unsigned)(s1 >> 32);
            const f32x4 a = *(const LAS f32x4*)(stg + row * STAGE_ROW + 64 * half + 8 * i) * (1.0f / 255.0f), c = *(const LAS f32x4*)(stg + row * STAGE_ROW + 64 * half + 8 * i + 4) * (1.0f / 255.0f); u32x4 w;
            w.x = cvtpk(a[0] * UB(ga, 0) + bf_lo(sx), a[1] * UB(ga, 1) + bf_hi(sx)); w.y = cvtpk(a[2] * UB(ga, 2) + bf_lo(sy), a[3] * UB(ga, 3) + bf_hi(sy));
            w.z = cvtpk(c[0] * UB(gc, 0) + bf_lo(sz), c[1] * UB(gc, 1) + bf_hi(sz)); w.w = cvtpk(c[2] * UB(gc, 2) + bf_lo(sw), c[3] * UB(gc, 3) + bf_hi(sw));
            if (!P.dry) *(u32x4*)(op + 8 * i) = w; }
    }
    WAIT_BAR(0);
}

__device__ __forceinline__ void attn_phase(const AttnP& P, int G, int vcu, char* shm) {
    for (int i = 0;; ++i) {
        const int L = i * G + vcu; if (L >= 1024) break;
        const int j = L >> 8, v = L & 255; const int bh = 32 * (j >> 1) + (v >> 3); const int qb = (j & 1) ? (v & 7) : 15 - (v & 7);
        const int b = bh >> 3, h = bh & 7;
        da_sub(P, b, h, qb * 256, false, shm);
        da_sub(P, b, h, qb * 256 + 128, true, shm);
        mla_unit(P, b, h, qb * 256, shm);
    }
}
#undef SBAR
#undef WAIT_BAR
}

constexpr int NWAVES = 8, NTHREADS = 512, NPHASE = 10;
struct Args { const void* in[28]; float* out; unsigned char* ws; int ph_lo, ph_hi, coop, rep_mask; };

__device__ __forceinline__ void transpose_item(const float* W, int N, int k0, int n0, bf16_t* WT, int ldk, int drow0, const float* kscale, LAS float* scr, int lane) {
#pragma unroll
    for (int i = 0; i < 32; ++i) { const int kk = 2 * i + (lane >> 5); float v = W[(size_t)(k0 + kk) * N + n0 + (lane & 31)]; if (kscale) v *= kscale[k0 + kk]; scr[kk * 33 + (lane & 31)] = v; }
    LDS_WAIT(); asm volatile("" ::: "memory");
    const int c = lane & 7;
#pragma unroll
    for (int j = 0; j < 4; ++j) { const int n = (lane >> 3) + 8 * j; const LAS float* s = scr + (8 * c) * 33 + n;
        u32x4 o; o.x = cvtpk(s[0 * 33], s[1 * 33]); o.y = cvtpk(s[2 * 33], s[3 * 33]); o.z = cvtpk(s[4 * 33], s[5 * 33]); o.w = cvtpk(s[6 * 33], s[7 * 33]);
        *(u32x4*)(WT + (size_t)(drow0 + n) * ldk + k0 + 8 * c) = o; }
    LDS_WAIT(); asm volatile("" ::: "memory");
}

__device__ __forceinline__ void ttb_load(f32x4 (&v)[8], const float* W, int N, int k0, int n0, int tid) {
    const int n4 = tid & 63, kr = tid >> 6;
#pragma unroll
    for (int p = 0; p < 8; ++p) v[p] = *(const f32x4*)(W + (size_t)(k0 + 8 * p + kr) * N + n0 + 4 * n4);
}
__device__ __forceinline__ void ttb_finish(const f32x4 (&v)[8], int k0, int n0, bf16_t* WT, int ldk, int is3, LAS float* T, int tid) {
    const int n4 = tid & 63, kr = tid >> 6;
#pragma unroll
    for (int p = 0; p < 8; ++p) *(LAS f32x4*)(T + (8 * p + kr) * 256 + 4 * (n4 ^ p)) = v[p];
    __syncthreads();
    const int c = tid & 7, nb = tid >> 3;
#pragma unroll
    for (int j = 0; j < 4; ++j) { const int n = nb + 64 * j; const LAS float* sp = T + (8 * c) * 256 + (n ^ (c << 2));
        u32x4 o; o.x = cvtpk(sp[0], sp[256]); o.y = cvtpk(sp[512], sp[768]); o.z = cvtpk(sp[1024], sp[1280]); o.w = cvtpk(sp[1536], sp[1792]);
        const int nn = n0 + n; const int drow = is3 < 0 ? nn : (256 * (nn >> 7) + 128 * is3 + (nn & 127));
        *(u32x4*)(WT + (size_t)drow * ldk + k0 + 8 * c) = o; }
    __syncthreads();
}

__device__ __forceinline__ void sincos_d(double a, float& s, float& c) {
    const double TWO_PI = 6.283185307179586, TWO_PI_LO = 2.4492935982947064e-16, HALF_PI = 1.5707963267948966;
    const double k = __builtin_rint(a * (1.0 / TWO_PI));
    double r = __builtin_fma(-k, TWO_PI, a); r = __builtin_fma(-k, TWO_PI_LO, r);
    const double q = __builtin_rint(r * (1.0 / HALF_PI)); const double y = __builtin_fma(-q, HALF_PI, r);
    const double y2 = y * y;
    double sp = -1.0 / 6227020800.0; sp = sp * y2 + 1.0 / 39916800.0; sp = sp * y2 - 1.0 / 362880.0; sp = sp * y2 + 1.0 / 5040.0; sp = sp * y2 - 1.0 / 120.0; sp = sp * y2 + 1.0 / 6.0; sp = y - y * y2 * sp;
    double cp = 1.0 / 479001600.0; cp = cp * y2 - 1.0 / 3628800.0; cp = cp * y2 + 1.0 / 40320.0; cp = cp * y2 - 1.0 / 720.0; cp = cp * y2 + 1.0 / 24.0; cp = cp * y2 - 0.5; cp = 1.0 + y2 * cp;
    const int qi = ((int)q) & 3;
    const double ss = (qi == 0) ? sp : (qi == 1) ? cp : (qi == 2) ? -sp : -cp;
    const double cc = (qi == 0) ? cp : (qi == 1) ? -sp : (qi == 2) ? -cp : sp;
    s = (float)ss; c = (float)cc;
}

#define DPPF(v_, CTRL_) __builtin_bit_cast(float, __builtin_amdgcn_update_dpp(__builtin_bit_cast(int, (v_)), __builtin_bit_cast(int, (v_)), (CTRL_), 0xF, 0xF, false))
__device__ __forceinline__ float rows_sum(float w) {
    w += DPPF(w, 0x124); w += DPPF(w, 0x128);
    { auto r = __builtin_amdgcn_permlane16_swap(__float_as_uint(w), __float_as_uint(w), false, false); w = __uint_as_float(r[0]) + __uint_as_float(r[1]); }
    { auto r = __builtin_amdgcn_permlane32_swap(__float_as_uint(w), __float_as_uint(w), false, false); w = __uint_as_float(r[0]) + __uint_as_float(r[1]); }
    return w;
}
__device__ __forceinline__ float red4(const float (&a)[4], bool b0, bool b1) {
    const float u0 = (b0 ? a[1] : a[0]) + DPPF(b0 ? a[0] : a[1], 0xB1), u1 = (b0 ? a[3] : a[2]) + DPPF(b0 ? a[2] : a[3], 0xB1);
    return rows_sum((b1 ? u1 : u0) + DPPF(b1 ? u0 : u1, 0x4E));
}
__device__ __forceinline__ void red8(const float (&a)[8], bool b0, bool b1, float& w0, float& w1) {
    float u[4];
#pragma unroll
    for (int i = 0; i < 4; ++i) u[i] = (b0 ? a[2 * i + 1] : a[2 * i]) + DPPF(b0 ? a[2 * i] : a[2 * i + 1], 0xB1);
    w0 = rows_sum((b1 ? u[1] : u[0]) + DPPF(b1 ? u[0] : u[1], 0x4E));
    w1 = rows_sum((b1 ? u[3] : u[2]) + DPPF(b1 ? u[2] : u[3], 0x4E));
}
#define RDLANE(v_, L_) __builtin_bit_cast(float, __builtin_amdgcn_readlane(__builtin_bit_cast(int, (v_)), (L_)))

#define XB_TMO      128
#define XB_XCNT(j)  (256  + 64 * (j))
#define XB_XSUB(j)  (1280 + 64 * (j))
#define XB_XGEN(j)  (2304 + 64 * (j))
#define XB_TOP      3328
#define XB_TOPGEN   3392
#define XCD_BAR_WORDS 3456
#define XB_SPIN_CAP (1u << 18)
__device__ __forceinline__ unsigned xb_ld(unsigned* p)              { return __hip_atomic_load(p, __ATOMIC_RELAXED, __HIP_MEMORY_SCOPE_AGENT); }
__device__ __forceinline__ unsigned xb_add(unsigned* p, unsigned v) { return __hip_atomic_fetch_add(p, v, __ATOMIC_RELAXED, __HIP_MEMORY_SCOPE_AGENT); }
__device__ __forceinline__ unsigned xb_xcc_id() { return (unsigned)__builtin_amdgcn_s_getreg((3 << 11) | 20) & 0xFu; }
#define XB_SPIN(cond, bar) do { unsigned _sp = 0; while (cond) { __builtin_amdgcn_s_sleep(1); \
    if ((++_sp & 255u) == 0u) { if (xb_ld(&(bar)[XB_TMO])) break; if (_sp > XB_SPIN_CAP) { atomicAdd(&(bar)[XB_TMO], 1u); break; } } } } while (0)
struct XcdBarrier { unsigned* bar; unsigned x; volatile LAS unsigned* st; };
__device__ __forceinline__ XcdBarrier xcd_barrier_post(unsigned* bar, volatile LAS unsigned* st) {
    XcdBarrier b; b.bar = bar; b.x = xb_xcc_id(); b.st = st;
    if (threadIdx.x == 0) (void)xb_add(&bar[XB_XCNT(b.x)], 1u);
    return b;
}
__device__ __forceinline__ void xcd_barrier_complete(unsigned* bar, unsigned x, unsigned& nloc, unsigned& nx) {
    const unsigned G = gridDim.x * gridDim.y * gridDim.z;
    unsigned sum, cnt, mine, sp = 0u;
    for (;;) {
        sum = 0u; cnt = 0u; mine = 0u;
#pragma unroll
        for (unsigned j = 0; j < 16; ++j) { const unsigned c = xb_ld(&bar[XB_XCNT(j)]); sum += c; cnt += (c > 0u) ? 1u : 0u; mine = (j == x) ? c : mine; }
        if (sum == G) break;
        __builtin_amdgcn_s_sleep(1);
        if ((++sp & 255u) == 0u) { if (xb_ld(&bar[XB_TMO])) break; if (sp > XB_SPIN_CAP) { atomicAdd(&bar[XB_TMO], 1u); break; } }
    }
    nloc = mine > 0u ? mine : 1u; nx = cnt > 0u ? cnt : 1u;
}
__device__ __forceinline__ void xcd_barrier(const XcdBarrier& b) {
    asm volatile("s_waitcnt vmcnt(0)" ::: "memory");
    __syncthreads();
    if (threadIdx.x == 0) {
        unsigned* bar = b.bar;
        __builtin_amdgcn_s_waitcnt(0);
        unsigned nloc = b.st[0], nx = b.st[1];
        if (nloc == 0u) { xcd_barrier_complete(bar, b.x, nloc, nx); b.st[0] = nloc; b.st[1] = nx; }
        const unsigned old = xb_add(&bar[XB_XSUB(b.x)], 1u);
        const unsigned gen = old / nloc;
        if (old + 1u == (gen + 1u) * nloc) {
            __builtin_amdgcn_fence(__ATOMIC_RELEASE, "agent");
            asm volatile("s_waitcnt vmcnt(0)" ::: "memory");
            const unsigned og = xb_add(&bar[XB_TOP], 1u);
            const unsigned tg = og / nx;
            if (og + 1u == (tg + 1u) * nx) xb_add(&bar[XB_TOPGEN], 1u);
            else XB_SPIN(xb_ld(&bar[XB_TOPGEN]) == tg, bar);
            __builtin_amdgcn_fence(__ATOMIC_ACQUIRE, "agent");
            xb_add(&bar[XB_XGEN(b.x)], 1u);
            asm volatile("s_waitcnt vmcnt(0)" ::: "memory");
        } else {
            XB_SPIN(xb_ld(&bar[XB_XGEN(b.x)]) == gen, bar);
            __builtin_amdgcn_fence(__ATOMIC_ACQUIRE, "agent");
            asm volatile("s_waitcnt vmcnt(0)" ::: "memory");
        }
    }
    __syncthreads();
}

__global__ void __launch_bounds__(NTHREADS, 2) hybrid_fwd(Args args) {
    extern __shared__ __attribute__((aligned(16))) unsigned char lds_raw[];
    LAS unsigned char* lds = (LAS unsigned char*)lds_raw;
    const int wave = __builtin_amdgcn_readfirstlane((int)threadIdx.x >> 6);
    const int G = gridDim.x, bx = blockIdx.x;
    const int vcu = (G % 8 == 0) ? (bx % 8) * (G / 8) + bx / 8 : bx;
    const int gw = vcu * NWAVES + wave, NGW = G * NWAVES;
    unsigned char* ws = args.ws;
    unsigned* ctl = (unsigned*)(ws + WS_CTL);
    const float* x = (const float*)args.in[0]; const int* positions = (const int*)args.in[1]; const float* attn_norm_g = (const float*)args.in[2];
    const float* w_in = (const float*)args.in[3]; const float* b_gate = (const float*)args.in[4]; const float* da_q_g = (const float*)args.in[5]; const float* da_k_g = (const float*)args.in[6];
    const float* lq1 = (const float*)args.in[7]; const float* lk1 = (const float*)args.in[8]; const float* lq2 = (const float*)args.in[9]; const float* lk2 = (const float*)args.in[10];
    const float* subln_g = (const float*)args.in[11]; const float* q_lora_g = (const float*)args.in[12]; const float* w_uq = (const float*)args.in[13];
    const float* kv_lora_g = (const float*)args.in[14]; const float* w_ukv = (const float*)args.in[15]; const float* mla_q_g = (const float*)args.in[16];
    const float* k_nope_g = (const float*)args.in[17]; const float* k_rope_g = (const float*)args.in[18]; const float* w_o = (const float*)args.in[19];
    const float* ffn_norm_g = (const float*)args.in[20]; const float* w_group = (const float*)args.in[21]; const float* b_group = (const float*)args.in[22];
    const float* w_router = (const float*)args.in[23]; const float* b_router = (const float*)args.in[24];
    const float* w1 = (const float*)args.in[25]; const float* w3 = (const float*)args.in[26]; const float* w2 = (const float*)args.in[27];
    float* out = args.out;
    float* rope_da = (float*)(ws + WS_ROPE_DA); float* rope_ml = (float*)(ws + WS_ROPE_ML); float* ssq = (float*)(ws + WS_SSQ);
    int* tok_e = (int*)(ws + WS_TOKE); float* tok_w = (float*)(ws + WS_TOKW); int* tok_p = (int*)(ws + WS_TOKP);
    int* row_tok = (int*)(ws + WS_ROWTOK); int* row_slot = (int*)(ws + WS_ROWSLOT); float* row_w = (float*)(ws + WS_ROWW); int* chunk_tbl = (int*)(ws + WS_CHUNKE);
    bf16_t* Wt_in = (bf16_t*)(ws + WS_WIN); bf16_t* Wt_uq = (bf16_t*)(ws + WS_WUQ); bf16_t* Wt_ukv = (bf16_t*)(ws + WS_WUKV); bf16_t* Wt_o = (bf16_t*)(ws + WS_WO);
    bf16_t* krope = (bf16_t*)(ws + WS_KROPE); bf16_t* cq = (bf16_t*)(ws + WS_CQ); bf16_t* ckv = (bf16_t*)(ws + WS_CKV); bf16_t* x1b = (bf16_t*)(ws + WS_X1);
    bf16_t* daq = (bf16_t*)(ws + WS_DAQ); bf16_t* dak = (bf16_t*)(ws + WS_DAK); bf16_t* dav = (bf16_t*)(ws + WS_DAV);
    bf16_t* hb = (bf16_t*)(ws + WS_H); bf16_t* mq = (bf16_t*)(ws + WS_MQ); bf16_t* mkv = (bf16_t*)(ws + WS_MKV);
    bf16_t* W13t = (bf16_t*)(ws + WS_W13); bf16_t* W2t = (bf16_t*)(ws + WS_W2); bf16_t* h2 = (bf16_t*)(ws + WS_H2); bf16_t* he = (bf16_t*)(ws + WS_HE); bf16_t* yb = (bf16_t*)(ws + WS_Y);
    unsigned char* gates = (unsigned char*)out;

    const int lo = args.ph_lo, hi_ph = args.ph_hi;
    { const int tid = otid(); if (tid < 128) ((LAS unsigned*)(lds + MISC_OFF))[tid] = 0u; }
    __syncthreads();
    if (args.coop == 2) cg::this_grid().sync();
    XcdBarrier gbar; gbar.bar = ctl + CW_BAR; gbar.x = 0; gbar.st = nullptr;
    if (args.coop) gbar = xcd_barrier_post(ctl + CW_BAR, (volatile LAS unsigned*)(lds + MISC_OFF) + 8);
#ifndef PHASE_MASK
#define PHASE_MASK 0x3ff
#endif
#define IN(k) (((PHASE_MASK >> (k)) & 1) && lo <= (k) && (k) < hi_ph)
#define REPS(k) for (int rep_ = 0, nr_ = 1 + ((args.rep_mask >> (k)) & 1); rep_ < nr_; ++rep_)
#define DRY (rep_ + 1 < nr_)
#define SEAM(k) do { if (IN(k) && IN((k) + 1)) { xcd_barrier(gbar); } } while (0)

    if (IN(0)) REPS(0) {
        const int tid = otid(), lane = tid & 63; (void)tid;
        LAS float* scr = (LAS float*)(lds + wave * 16384);
        constexpr int I_IN = 16 * 182, I_UQ = 6 * 48, I_UKV = 4 * 64, I_O = 16 * 32, NIT = I_IN + I_UQ + I_UKV + I_O;
        for (int it = gw; it < NIT; it += NGW) {
            int r = it;
            if (r < I_IN) { const int kb = r / 182, nb = r % 182, n0 = nb * 32; transpose_item(w_in, IN_COLS, kb * 64, n0, Wt_in, 1024, n0 < C_PAD ? n0 : n0 + 64, nullptr, scr, lane); continue; } r -= I_IN;
            if (r < I_UQ) { const int kb = r / 48, nb = r % 48; transpose_item(w_uq, MQ_N, kb * 64, nb * 32, Wt_uq, QLORA, nb * 32, q_lora_g, scr, lane); continue; } r -= I_UQ;
            if (r < I_UKV) { const int kb = r / 64, nb = r % 64; transpose_item(w_ukv, MKV_N, kb * 64, nb * 32, Wt_ukv, KVLORA, nb * 32, kv_lora_g, scr, lane); continue; } r -= I_UKV;
            { const int kb = r / 32, nb = r % 32; transpose_item(w_o, DM, kb * 64, nb * 32, Wt_o, DM, nb * 32, nullptr, scr, lane); }
        }
        for (int i = gw * 64 + lane; i < 64 * 1024 / 8; i += NGW * 64) *(u32x4*)(Wt_in + (size_t)C_PAD * 1024 + (size_t)i * 8) = (u32x4){0u, 0u, 0u, 0u};
        const bool rda = lane < 8; const int ri = rda ? lane : lane - 8;
        double rinvf = 1.0; { const double base = rda ? 0.19392274474868576 : 0.6636012376960885; for (int k = 0; k < ri && lane < 40; ++k) rinvf *= base; }
        f32x4 gA[4];
#pragma unroll
        for (int j = 0; j < 4; ++j) gA[j] = ((const f32x4*)attn_norm_g + lane)[64 * j];
        auto rows_ld = [&](f32x4 (&v4)[4][4], int (&pos4)[4], const int m0) __attribute__((always_inline)) {
#pragma unroll
            for (int r = 0; r < 4; ++r) { const int mr = (m0 + r * NGW < MTOK) ? m0 + r * NGW : gw; pos4[r] = positions[mr]; const f32x4* xr = (const f32x4*)(x + (size_t)mr * DM) + lane;
#pragma unroll
                for (int j = 0; j < 4; ++j) v4[r][j] = xr[64 * j]; }
        };
        auto rows_do = [&](const f32x4 (&v4)[4][4], const int (&pos4)[4], const int m0) __attribute__((always_inline)) {
#pragma unroll
          for (int r = 0; r < 4; ++r) { const int m = m0 + r * NGW; if (m < MTOK) {
            float s = 0.f;
#pragma unroll
            for (int j = 0; j < 4; ++j) { const f32x4 t = v4[r][j]; s += (t[0] * t[0] + t[1] * t[1]) + (t[2] * t[2] + t[3] * t[3]); }
            const float rinv = __builtin_amdgcn_rsqf(wave_sum(s) * (1.0f / DM) + NORM_EPS);
            u32x2* o8 = (u32x2*)(hb + (size_t)m * DM) + lane;
#pragma unroll
            for (int j = 0; j < 4; ++j) { const f32x4 g = gA[j], t = v4[r][j]; u32x2 w; w.x = cvtpk(t[0] * rinv * g[0], t[1] * rinv * g[1]); w.y = cvtpk(t[2] * rinv * g[2], t[3] * rinv * g[3]); o8[64 * j] = w; }
            if (lane < 40) {
                float sn, cs; sincos_d((double)pos4[r] * rinvf, sn, cs);
                if (rda) { rope_da[(size_t)m * 16 + ri] = cs; rope_da[(size_t)m * 16 + 8 + ri] = sn; } else { rope_ml[(size_t)m * 64 + ri] = cs; rope_ml[(size_t)m * 64 + 32 + ri] = sn; }
            }
          } }
        };
        { f32x4 va[4][4], vb[4][4]; int pa[4], pb[4];
          rows_ld(va, pa, gw);
          for (int m0 = gw; m0 < MTOK; m0 += 8 * NGW) {
              rows_ld(vb, pb, m0 + 4 * NGW);
              rows_do(va, pa, m0);
              if (m0 + 4 * NGW >= MTOK) break;
              rows_ld(va, pa, m0 + 8 * NGW);
              rows_do(vb, pb, m0 + 4 * NGW);
          } }
    }
    SEAM(0);

    if (IN(1)) REPS(1) {
        pg8::DenseOrder S; S.init(MTOK, NINP, G, bx);
        epi::EpiInProj E{daq, dak, dav, cq, ckv, krope, gates, ssq, da_q_g, da_k_g, k_rope_g, b_gate, rope_da, rope_ml, DRY};
        pg8::gemm_phase<epi::EpiInProj, pg8::DenseOrder, true>(lds, hb, Wt_in, DM, S, E);
    }
    SEAM(1);

    if (IN(2)) REPS(2) {
        { pg8::DenseOrder S; S.init(MTOK, MQ_N, G, bx); epi::EpiMlaQ E{mq, ssq}; pg8::gemm_phase<epi::EpiMlaQ, pg8::DenseOrder, true>(lds, cq, Wt_uq, QLORA, S, E); }
        { pg8::DenseOrder S; S.init(MTOK, MKV_N, G, bx); epi::EpiMlaKV E{mkv, ssq, k_nope_g}; pg8::gemm_phase<epi::EpiMlaKV, pg8::DenseOrder, true>(lds, ckv, Wt_ukv, KVLORA, S, E); }
    }
    SEAM(2);

    if (IN(3)) REPS(3) {
        float d1 = 0.f, d2 = 0.f;
        for (int i = 0; i < 64; ++i) { d1 += lq1[i] * lk1[i]; d2 += lq2[i] * lk2[i]; }
        att::AttnP P{daq, dak, dav, mq, mkv, krope, gates, daq, subln_g, mla_q_g, rope_ml, __expf(d1) - __expf(d2) + LAMBDA_INIT, DRY, (PROBE_VARIANTS && DRY) ? (args.rep_mask >> 16) : 0};
        att::attn_phase(P, G, vcu, (char*)lds_raw);
    }
    SEAM(3);

    if (IN(4)) REPS(4) {
        const int tid = otid(), lane = tid & 63; (void)tid;
#define TILE_DESC(it_, W_, N_, k0_, n0_, WT_, ldk_, is3_) do { const int e_ = (it_) / 96, r_ = (it_) % 96; \
            if (r_ < 64) { is3_ = r_ >> 5; const int q_ = r_ & 31; k0_ = (q_ >> 1) * 64; n0_ = (q_ & 1) * 256; W_ = (is3_ ? w3 : w1) + (size_t)e_ * DM * DEXP; N_ = DEXP; WT_ = W13t + (size_t)e_ * 1024 * 1024; ldk_ = 1024; } \
            else { const int q_ = r_ - 64; is3_ = -1; k0_ = (q_ >> 2) * 64; n0_ = (q_ & 3) * 256; W_ = w2 + (size_t)e_ * DEXP * DM; N_ = DM; WT_ = W2t + (size_t)e_ * 1024 * 512; ldk_ = 512; } } while (0)
        { f32x4 va[8] = {}, vb[8] = {}; const float *Wa = w1, *Wb = w1; int Na = 0, k0a = 0, n0a = 0, ldka = 0, is3a = 0, Nb = 0, k0b = 0, n0b = 0, ldkb = 0, is3b = 0; bf16_t *WTa = W13t, *WTb = W13t;
          constexpr int NT_ = NEXP * 96;
          int it = bx;
          if (it < NT_) { TILE_DESC(it, Wa, Na, k0a, n0a, WTa, ldka, is3a); ttb_load(va, Wa, Na, k0a, n0a, tid); }
          for (; it < NT_; it += 2 * G) {
              const bool hb_ = it + G < NT_;
              if (hb_) { TILE_DESC(it + G, Wb, Nb, k0b, n0b, WTb, ldkb, is3b); ttb_load(vb, Wb, Nb, k0b, n0b, tid); }
              ttb_finish(va, k0a, n0a, WTa, ldka, is3a, (LAS float*)lds, tid);
              if (!hb_) break;
              if (it + 2 * G < NT_) { TILE_DESC(it + 2 * G, Wa, Na, k0a, n0a, WTa, ldka, is3a); ttb_load(va, Wa, Na, k0a, n0a, tid); }
              ttb_finish(vb, k0b, n0b, WTb, ldkb, is3b, (LAS float*)lds, tid);
          } }
#undef TILE_DESC
        __syncthreads();
        pg8::DenseOrder S; S.init(MTOK, DM, G, bx);
        epi::EpiOut E{x, x1b};
        pg8::gemm_phase<epi::EpiOut, pg8::DenseOrder, true>(lds, daq, Wt_o, DM, S, E);
    }
    SEAM(4);

    if (IN(5)) REPS(5) {
        const bool dry = DRY;
        const int tid = otid(), lane = tid & 63;
        LAS float* Wl = (LAS float*)lds;
        LAS unsigned* misc = (LAS unsigned*)(lds + MISC_OFF);
#define KPOS(k_) ((((k_) >> 9) * 2 + (((k_) >> 2) & 1)) * 256 + (((k_) >> 3) & 63) * 4 + ((k_) & 3))
        for (int i = tid; i < 1024; i += NTHREADS) { const f32x4 w = ((const f32x4*)w_group)[i]; const int kp = KPOS(i);
            Wl[kp] = w[0]; Wl[1024 + kp] = w[1]; Wl[2048 + kp] = w[2]; Wl[3072 + kp] = w[3]; }
        for (int i = tid; i < 8 * 1024; i += NTHREADS) { const f32x4 w = ((const f32x4*)w_router)[i]; const int k = i >> 3, n0 = (i & 7) * 4, kp = KPOS(k);
            Wl[4096 + n0 * 1024 + kp] = w[0]; Wl[4096 + (n0 + 1) * 1024 + kp] = w[1]; Wl[4096 + (n0 + 2) * 1024 + kp] = w[2]; Wl[4096 + (n0 + 3) * 1024 + kp] = w[3]; }
#undef KPOS
        if (tid < 32) { misc[32 + tid] = 0u; ((LAS float*)misc)[96 + tid] = b_router[tid]; }
        const float bg0 = b_group[0], bg1 = b_group[1], bg2 = b_group[2], bg3 = b_group[3];
        for (int r = bx * NTHREADS + tid; r < PROWS; r += G * NTHREADS) { row_tok[r] = 0; row_slot[r] = -1; row_w[r] = 0.f; }
        __syncthreads();
        int rt_ = -1, re0 = 0, re1 = 0, rp0 = 0, rp1 = 0; float rw0 = 0.f, rw1 = 0.f;
        int it = 0;
        u32x4 vn[2], vq[2]; f32x4 gF[4];
#pragma unroll
        for (int j = 0; j < 4; ++j) gF[j] = ((const f32x4*)ffn_norm_g)[128 * (j >> 1) + 2 * lane + (j & 1)];
#pragma unroll
        for (int jj = 0; jj < 2; ++jj) { vn[jj] = (gw < MTOK) ? ((const u32x4*)(x1b + (size_t)gw * DM) + lane)[64 * jj] : (u32x4){0u, 0u, 0u, 0u};
            vq[jj] = (gw + NGW < MTOK) ? ((const u32x4*)(x1b + (size_t)(gw + NGW) * DM) + lane)[64 * jj] : (u32x4){0u, 0u, 0u, 0u}; }
        __builtin_amdgcn_s_waitcnt(0x0F70);
        auto route = [&](f32x4 (&v)[4], const int m) __attribute__((always_inline)) {
            float s = 0.f;
#pragma unroll
            for (int j = 0; j < 4; ++j) s += (v[j][0] * v[j][0] + v[j][1] * v[j][1]) + (v[j][2] * v[j][2] + v[j][3] * v[j][3]);
            const float rinv = __builtin_amdgcn_rsqf(wave_sum(s) * (1.0f / DM) + NORM_EPS);
            u32x4* o8 = (u32x4*)(h2 + (size_t)m * DM) + lane;
#pragma unroll
            for (int j = 0; j < 4; ++j) v[j] = v[j] * rinv * gF[j];
#pragma unroll
            for (int jj = 0; jj < 2; ++jj) { u32x4 w; w.x = cvtpk(v[2 * jj][0], v[2 * jj][1]); w.y = cvtpk(v[2 * jj][2], v[2 * jj][3]); w.z = cvtpk(v[2 * jj + 1][0], v[2 * jj + 1][1]); w.w = cvtpk(v[2 * jj + 1][2], v[2 * jj + 1][3]); o8[64 * jj] = w; }
            const bool lb0 = lane & 1, lb1 = (lane >> 1) & 1;
            float gl[4];
            { float pa[4];
#pragma unroll
              for (int n = 0; n < 4; ++n) { f32x2 a2 = {0.f, 0.f};
#pragma unroll
                  for (int j = 0; j < 4; ++j) { const f32x4 w = *(const LAS f32x4*)(Wl + n * 1024 + 256 * j + 4 * lane);
                      a2 = (f32x2){v[j][0], v[j][1]} * (f32x2){w[0], w[1]} + a2; a2 = (f32x2){v[j][2], v[j][3]} * (f32x2){w[2], w[3]} + a2; }
                  pa[n] = a2[0] + a2[1]; }
              const float t = red4(pa, lb0, lb1);
              gl[0] = RDLANE(t, 0) + bg0; gl[1] = RDLANE(t, 1) + bg1; gl[2] = RDLANE(t, 2) + bg2; gl[3] = RDLANE(t, 3) + bg3; }
            int gs = 0; float gm = gl[0];
#pragma unroll
            for (int n = 1; n < 4; ++n) if (gl[n] > gm) { gm = gl[n]; gs = n; }
            float gden = 0.f;
#pragma unroll
            for (int n = 0; n < 4; ++n) gden += __expf(gl[n] - gm);
            const float pg = 1.0f / gden;
            gs = __builtin_amdgcn_readfirstlane(gs);
            float el[8];
            { float pa[8];
#pragma unroll
              for (int n = 0; n < 8; ++n) { f32x2 a2 = {0.f, 0.f}; const LAS float* wp = Wl + 4096 + (gs * 8 + n) * 1024 + 4 * lane;
#pragma unroll
                  for (int j = 0; j < 4; ++j) { const f32x4 w = *(const LAS f32x4*)(wp + 256 * j);
                      a2 = (f32x2){v[j][0], v[j][1]} * (f32x2){w[0], w[1]} + a2; a2 = (f32x2){v[j][2], v[j][3]} * (f32x2){w[2], w[3]} + a2; }
                  pa[n] = a2[0] + a2[1]; }
              float t0, t1; red8(pa, lb0, lb1, t0, t1);
              const LAS float* bb = (const LAS float*)misc + 96 + gs * 8;
#pragma unroll
              for (int n = 0; n < 4; ++n) { el[n] = RDLANE(t0, n) + bb[n]; el[4 + n] = RDLANE(t1, n) + bb[4 + n]; } }
            int i0 = 0; float v0 = el[0];
#pragma unroll
            for (int n = 1; n < 8; ++n) if (el[n] > v0) { v0 = el[n]; i0 = n; }
            int i1 = -1; float v1 = 0.f;
#pragma unroll
            for (int n = 0; n < 8; ++n) if (n != i0 && (i1 < 0 || el[n] > v1)) { v1 = el[n]; i1 = n; }
            const float ex = __expf(v1 - v0); const float wa = pg / (1.0f + ex), wb = pg * ex / (1.0f + ex);
            const int e0 = gs * 8 + i0, e1 = gs * 8 + i1;
            int p0 = 0, p1 = 0;
            if (lane == 0) { p0 = (int)__hip_atomic_fetch_add(misc + 32 + e0, 1u, __ATOMIC_RELAXED, __HIP_MEMORY_SCOPE_WORKGROUP); p1 = (int)__hip_atomic_fetch_add(misc + 32 + e1, 1u, __ATOMIC_RELAXED, __HIP_MEMORY_SCOPE_WORKGROUP); }
            p0 = __shfl(p0, 0); p1 = __shfl(p1, 0);
            if (lane == it) { rt_ = m; re0 = e0; re1 = e1; rp0 = p0; rp1 = p1; rw0 = wa; rw1 = wb; }
        };
#define ROW_CVT(v_, b_) do { _Pragma("unroll") for (int jj = 0; jj < 2; ++jj) { v_[2 * jj] = (f32x4){bf_lo(b_[jj].x), bf_hi(b_[jj].x), bf_lo(b_[jj].y), bf_hi(b_[jj].y)}; v_[2 * jj + 1] = (f32x4){bf_lo(b_[jj].z), bf_hi(b_[jj].z), bf_lo(b_[jj].w), bf_hi(b_[jj].w)}; } } while (0)
#define ROW_LD(b_, m_) do { const int mm_ = (m_) < MTOK ? (m_) : gw; const u32x4* xn_ = (const u32x4*)(x1b + (size_t)mm_ * DM) + lane; b_[0] = xn_[0]; b_[1] = xn_[64]; } while (0)
        for (int m = gw; m < MTOK; m += 2 * NGW) {
            f32x4 v[4];
            ROW_CVT(v, vn); ROW_LD(vn, m + 2 * NGW);
            route(v, m); ++it;
            if (m + NGW >= MTOK) break;
            ROW_CVT(v, vq); ROW_LD(vq, m + 3 * NGW);
            route(v, m + NGW); ++it;
        }
#undef ROW_CVT
#undef ROW_LD
        __syncthreads();
        if (tid < 32) misc[64 + tid] = __hip_atomic_fetch_add(ctl + CW_GCNT + tid, dry ? 0u : misc[32 + tid], __ATOMIC_RELAXED, __HIP_MEMORY_SCOPE_AGENT);
        __syncthreads();
        if (rt_ >= 0 && !dry) { tok_e[2 * rt_] = re0; tok_e[2 * rt_ + 1] = re1; tok_w[2 * rt_] = rw0; tok_w[2 * rt_ + 1] = rw1;
            tok_p[2 * rt_] = (int)misc[64 + re0] + rp0; tok_p[2 * rt_ + 1] = (int)misc[64 + re1] + rp1; }
    }
    SEAM(5);

    if (IN(6)) REPS(6) {
        const int tid = otid();
        LAS int* cs = (LAS int*)(lds + MISC_OFF) + 90;
        if (tid == 0) { int acc_ = 0; for (int e = 0; e < NEXP; ++e) { cs[e] = acc_; acc_ += ((int)__hip_atomic_load(ctl + CW_GCNT + e, __ATOMIC_RELAXED, __HIP_MEMORY_SCOPE_AGENT) + 255) >> 8; } cs[NEXP] = acc_; }
        __syncthreads();
        if (bx == 0) { if (tid == 0) chunk_tbl[0] = cs[NEXP]; for (int e = tid; e < NEXP; e += NTHREADS) for (int c = cs[e]; c < cs[e + 1]; ++c) chunk_tbl[16 + c] = e; }
        for (int t = bx * NTHREADS + tid; t < MTOK; t += G * NTHREADS) {
#pragma unroll
            for (int k = 0; k < 2; ++k) { const int e = tok_e[2 * t + k]; const int r = 256 * cs[e] + tok_p[2 * t + k]; row_tok[r] = t; row_slot[r] = 2 * t + k; row_w[r] = tok_w[2 * t + k]; }
        }
    }
    SEAM(6);

    if (IN(7)) REPS(7) {
        pg8::GroupOrder<true> S{4 * chunk_tbl[0], G, vcu, chunk_tbl + 16, row_tok};
        epi::EpiSwiglu E{he, ctl + CW_DONE};
        pg8::gemm_phase<epi::EpiSwiglu, pg8::GroupOrder<true>, true>(lds, h2, W13t, DM, S, E);
    }

    if (IN(8)) REPS(8) {
        pg8::GroupOrderBal S{4 * chunk_tbl[0], G, vcu, chunk_tbl + 16, row_tok, ctl + CW_DONE};
        epi::EpiDown E{yb, row_slot, row_w};
        pg8::gemm_phase<epi::EpiDown, pg8::GroupOrderBal, true>(lds, he, W2t, DEXP, S, E);
    }
    SEAM(8);

    if (IN(9)) REPS(9) {
        const bool dry = DRY;
        const int lane = otid() & 63;
        for (int m0 = gw; m0 < MTOK; m0 += 4 * NGW) {
            u32x2 v[4][4], ya[4][4], yc[4][4];
#pragma unroll
            for (int r = 0; r < 4; ++r) { const int m = m0 + r * NGW; if (m < MTOK) {
                const u32x2* xr = (const u32x2*)(x1b + (size_t)m * DM) + lane; const u32x2* y0 = (const u32x2*)(yb + (size_t)(2 * m) * DM) + lane; const u32x2* y1 = (const u32x2*)(yb + (size_t)(2 * m + 1) * DM) + lane;
#pragma unroll
                for (int j = 0; j < 4; ++j) { v[r][j] = xr[64 * j]; ya[r][j] = y0[64 * j]; yc[r][j] = y1[64 * j]; } } }
#pragma unroll
            for (int r = 0; r < 4; ++r) { const int m = m0 + r * NGW; if (m < MTOK) { f32x4* xr = (f32x4*)(out + (size_t)m * DM) + lane;
#pragma unroll
                for (int j = 0; j < 4; ++j) { const u32x2 c = v[r][j], a = ya[r][j], b = yc[r][j]; f32x4 w;
                    w[0] = bf_lo(c.x) + (bf_lo(a.x) + bf_lo(b.x)); w[1] = bf_hi(c.x) + (bf_hi(a.x) + bf_hi(b.x)); w[2] = bf_lo(c.y) + (bf_lo(a.y) + bf_lo(b.y)); w[3] = bf_hi(c.y) + (bf_hi(a.y) + bf_hi(b.y)); asm volatile("" : "+v"(w)); if (!dry) xr[64 * j] = w; } } }
        }
    }
#undef IN
#undef SEAM
#undef REPS
#undef DRY
}

extern "C" void kernel_launch(void* const* d_in, const int* in_sizes, int n_in, void* d_out, int out_size, void* d_ws, size_t ws_size, hipStream_t stream) {
    static int grid = 0;
    if (grid == 0) {
        if (n_in != 28 || out_size != MTOK * DM || ws_size < WS_END) { fprintf(stderr, "kernel_launch: unexpected shapes (n_in %d out %d ws %zu)\n", n_in, out_size, ws_size); grid = -1; return; }
        int dev = 0, cus = 0, per_cu = 0;
        hipGetDevice(&dev); hipDeviceGetAttribute(&cus, hipDeviceAttributeMultiprocessorCount, dev);
        hipFuncSetAttribute((const void*)hybrid_fwd, hipFuncAttributeMaxDynamicSharedMemorySize, LDS_BYTES);
        hipOccupancyMaxActiveBlocksPerMultiprocessor(&per_cu, (const void*)hybrid_fwd, NTHREADS, LDS_BYTES);
        (void)hipGetLastError();
        if (per_cu < 1) { fprintf(stderr, "kernel_launch: occupancy query says %d blocks/CU\n", per_cu); per_cu = 1; }
        grid = cus * 1;
    }
    if (grid < 0) return;
    hipMemsetAsync((char*)d_ws + WS_CTL, 0, CTL_ZERO_BYTES, stream);
    Args a{};
    for (int i = 0; i < 28; ++i) a.in[i] = d_in[i];
    a.out = (float*)d_out; a.ws = (unsigned char*)d_ws; a.rep_mask = PROBE_REP_MASK;
#if N_LAUNCH_SPLIT
    for (int p = 0; p < NPHASE; ++p) { a.ph_lo = p; a.ph_hi = p + 1; a.coop = 0; hipLaunchKernelGGL(hybrid_fwd, dim3(grid), dim3(NTHREADS), LDS_BYTES, stream, a); }
#else
    a.ph_lo = 0; a.ph_hi = NPHASE; a.coop = 1;
    void* kargs[] = {&a};
    hipError_t e = hipLaunchCooperativeKernel((const void*)hybrid_fwd, dim3(grid), dim3(NTHREADS), kargs, LDS_BYTES, stream);
    if (e != hipSuccess) fprintf(stderr, "cooperative launch failed: %s (grid %d)\n", hipGetErrorString(e), grid);
#endif
}
```
